# Optimizing an MI355X kernel written in HIP

```python
import math
import jax, jax.numpy as jnp
from jax import lax
import numpy as np

D_MODEL = 2048
BATCH = 8
SEQ = 2048
DEPTH = 2

DN_HEADS = 4
DN_DK = 128
DN_DV = 128
DIFF_HEADS = 8
DIFF_DH = 64
DIFF_DV = 2 * DIFF_DH
ML_HEADS = 4
ML_DH = 128
DN_W = DN_HEADS * DN_DV
DIFF_W = DIFF_HEADS * DIFF_DV
ML_W = ML_HEADS * ML_DH
D_MIX = DN_W + DIFF_W + ML_W
CONV_K = 4
DN_CHUNK = 64
ML_CHUNK = 64
Q_BLOCK = 128
SPLIT_SIZES = (3 * DN_W, 2 * ML_W, DN_W, DN_HEADS, DN_HEADS, 3 * DIFF_W, ML_W, ML_W, ML_HEADS, ML_HEADS)
N_IN = sum(SPLIT_SIZES)
D_FF = 7 * D_MODEL // 2
N_EXPERTS = 8
TOP_K = 2
N_DENSE = (DEPTH + 1) // 2
N_MOE = DEPTH // 2
PLE_DIM = 256
EPS = 1e-6

kernel_name = "hybrid_deltanet_diffattn_mlstm_moe_block"


def rms_norm(x, w):
    xf = x.astype(jnp.float32)
    y = xf * lax.rsqrt(jnp.mean(xf * xf, axis=-1, keepdims=True) + EPS)
    return (y * w.astype(jnp.float32)).astype(x.dtype)


def l2_normalize(x):
    xf = x.astype(jnp.float32)
    return xf * lax.rsqrt(jnp.sum(xf * xf, axis=-1, keepdims=True) + EPS)


def causal_dwconv_silu(x, w):
    y = lax.conv_general_dilated(
        x, w[:, None, :].astype(x.dtype), window_strides=(1,),
        padding=[(w.shape[0] - 1, 0)], dimension_numbers=("NWC", "WIO", "NWC"),
        feature_group_count=x.shape[-1])
    return jax.nn.silu(y)


def to_chunks(t, chunk):
    b, s, h = t.shape[:3]
    t = t.astype(jnp.float32).reshape((b, s // chunk, chunk, h) + t.shape[3:])
    return jnp.moveaxis(t, 3, 1)


def from_chunks(o):
    b, h, n, c, d = o.shape
    return jnp.moveaxis(o, 1, 3).reshape(b, n * c, h, d)


def gated_delta_rule(q, k, v, g, beta):
    B, S, H, dk = q.shape
    dv = v.shape[-1]
    C = DN_CHUNK
    q = to_chunks(l2_normalize(q), C) * (dk ** -0.5)
    k = to_chunks(l2_normalize(k), C)
    v = to_chunks(v, C)
    beta = to_chunks(beta, C)
    g = jnp.cumsum(to_chunks(g, C), axis=-1)
    tri_incl = jnp.tril(jnp.ones((C, C), bool))
    tri_strict = jnp.tril(jnp.ones((C, C), bool), -1)
    decay = jnp.exp(jnp.where(tri_incl, g[..., :, None] - g[..., None, :], -jnp.inf))
    k_beta = k * beta[..., None]
    a = jnp.where(tri_strict, jnp.einsum('bhnid,bhnjd->bhnij', k_beta, k) * decay, 0.0)
    rhs = jnp.concatenate([v * beta[..., None], k_beta * jnp.exp(g)[..., None]], axis=-1)
    sol = lax.linalg.triangular_solve(a, rhs, left_side=True, lower=True, unit_diagonal=True)
    u, w = sol[..., :dv], sol[..., dv:]
    attn = jnp.einsum('bhnid,bhnjd->bhnij', q, k) * decay
    q_g = q * jnp.exp(g)[..., None]
    k_g = k * jnp.exp(g[..., -1:] - g)[..., None]
    g_last = jnp.exp(g[..., -1])

    def step(state, xs):
        u_c, w_c, attn_c, qg_c, kg_c, gl_c = xs
        v_new = u_c - w_c @ state
        o = qg_c @ state + attn_c @ v_new
        state = state * gl_c[..., None, None] + jnp.swapaxes(kg_c, -1, -2) @ v_new
        return state, o

    xs = tuple(jnp.moveaxis(t, 2, 0) for t in (u, w, attn, q_g, k_g, g_last))
    _, o = lax.scan(step, jnp.zeros((B, H, dk, dv), jnp.float32), xs)
    return from_chunks(jnp.moveaxis(o, 0, 2))


def mlstm_chunked(q, k, v, i_pre, log_f):
    B, S, H, d = q.shape
    C = ML_CHUNK
    q = to_chunks(q, C)
    k = to_chunks(k, C) * (d ** -0.5)
    v = to_chunks(v, C)
    i_pre = to_chunks(i_pre, C)
    b = jnp.cumsum(to_chunks(log_f, C), axis=-1)
    tri = jnp.tril(jnp.ones((C, C), bool))
    dlog = jnp.where(tri, b[..., :, None] - b[..., None, :] + i_pre[..., None, :], -jnp.inf)
    dmax = jnp.max(dlog, axis=-1)
    qk = jnp.einsum('bhnid,bhnjd->bhnij', q, k)
    a = b[..., -1:] - b + i_pre
    a_max = jnp.max(a, axis=-1)
    b_last = b[..., -1]

    def step(carry, xs):
        c_st, n_st, m_st = carry
        q_c, k_c, v_c, qk_c, dlog_c, dmax_c, b_c, a_c, amax_c, bl_c = xs
        m_t = jnp.maximum(dmax_c, b_c + m_st[..., None])
        s = qk_c * jnp.exp(dlog_c - m_t[..., None])
        inter = jnp.exp(b_c + m_st[..., None] - m_t)
        num = s @ v_c + inter[..., None] * (q_c @ c_st)
        den = jnp.sum(s, axis=-1) + inter * jnp.einsum('bhcd,bhd->bhc', q_c, n_st)
        h = num / jnp.maximum(jnp.abs(den), jnp.exp(-m_t))[..., None]
        m_new = jnp.maximum(bl_c + m_st, amax_c)
        carry_scale = jnp.exp(bl_c + m_st - m_new)
        wk = k_c * jnp.exp(a_c - m_new[..., None])[..., None]
        c_new = carry_scale[..., None, None] * c_st + jnp.swapaxes(wk, -1, -2) @ v_c
        n_new = carry_scale[..., None] * n_st + jnp.sum(wk, axis=-2)
        return (c_new, n_new, m_new), h

    xs = tuple(jnp.moveaxis(t, 2, 0) for t in (q, k, v, qk, dlog, dmax, b, a, a_max, b_last))
    init = (jnp.zeros((B, H, d, d), jnp.float32), jnp.zeros((B, H, d), jnp.float32),
            jnp.zeros((B, H), jnp.float32))
    _, h = lax.scan(step, init, xs)
    return from_chunks(jnp.moveaxis(h, 0, 2))


def diff_attention(q, k, v, lam):
    B, S, H, _, dh = q.shape
    nb = S // Q_BLOCK
    slopes = 2.0 ** (-8.0 * jnp.arange(1, H + 1, dtype=jnp.float32) / H)
    qb = q.reshape(B, nb, Q_BLOCK, H, 2, dh).transpose(1, 0, 3, 4, 2, 5) * (dh ** -0.5)
    kt = k.transpose(0, 2, 3, 1, 4)
    vt = v.transpose(0, 2, 1, 3)
    pos_k = jnp.arange(S)

    def block(args):
        q_blk, blk = args
        pos_q = blk * Q_BLOCK + jnp.arange(Q_BLOCK)
        dist = pos_q[:, None] - pos_k[None, :]
        s = jnp.einsum('bhjqd,bhjkd->bhjqk', q_blk, kt).astype(jnp.float32)
        s = s - slopes[:, None, None, None] * dist.astype(jnp.float32)
        s = jnp.where(dist >= 0, s, -jnp.inf)
        pr = jax.nn.softmax(s, axis=-1)
        a = pr[:, :, 0] - lam * pr[:, :, 1]
        return jnp.einsum('bhqk,bhkd->bhqd', a.astype(vt.dtype), vt)

    o = lax.map(block, (qb, jnp.arange(nb)))
    return o.transpose(1, 0, 3, 2, 4).reshape(B, S, H, -1)


def hybrid_mixer(hn, w_in, conv_dn, conv_ml, dn_a_log, dn_dt_bias, dn_norm,
                 lq1, lk1, lq2, lk2, diff_norm, ml_i_bias, ml_f_bias, ml_norm, lambda_init):
    B, S, _ = hn.shape
    f32 = jnp.float32
    z = hn @ w_in
    split_points = [int(c) for c in np.cumsum(SPLIT_SIZES)[:-1]]
    (dn_qkv, ml_qk, dn_z, dn_b, dn_a, diff_qkv, ml_v, ml_o, ml_i, ml_f) = jnp.split(z, split_points, axis=-1)

    dn_qkv = causal_dwconv_silu(dn_qkv, conv_dn)
    dq, dkk, dvv = jnp.split(dn_qkv, 3, axis=-1)
    beta = jax.nn.sigmoid(dn_b.astype(f32))
    g = -jnp.exp(dn_a_log) * jax.nn.softplus(dn_a.astype(f32) + dn_dt_bias)
    o_dn = gated_delta_rule(dq.reshape(B, S, DN_HEADS, DN_DK), dkk.reshape(B, S, DN_HEADS, DN_DK),
                            dvv.reshape(B, S, DN_HEADS, DN_DV), g, beta)
    o_dn = rms_norm(o_dn, dn_norm) * jax.nn.silu(dn_z.reshape(B, S, DN_HEADS, DN_DV).astype(f32))

    aq, ak, av = jnp.split(diff_qkv, 3, axis=-1)
    lam = (jnp.exp(jnp.sum(lq1.astype(f32) * lk1.astype(f32)))
           - jnp.exp(jnp.sum(lq2.astype(f32) * lk2.astype(f32))) + lambda_init)
    o_diff = diff_attention(aq.reshape(B, S, DIFF_HEADS, 2, DIFF_DH), ak.reshape(B, S, DIFF_HEADS, 2, DIFF_DH),
                            av.reshape(B, S, DIFF_HEADS, DIFF_DV), lam)
    o_diff = rms_norm(o_diff, diff_norm).astype(f32) * (1.0 - lambda_init)

    ml_qk = causal_dwconv_silu(ml_qk, conv_ml)
    mq, mk = jnp.split(ml_qk, 2, axis=-1)
    i_pre = ml_i.astype(f32) + ml_i_bias
    log_f = jax.nn.log_sigmoid(ml_f.astype(f32) + ml_f_bias)
    o_ml = mlstm_chunked(mq.reshape(B, S, ML_HEADS, ML_DH), mk.reshape(B, S, ML_HEADS, ML_DH),
                         ml_v.reshape(B, S, ML_HEADS, ML_DH), i_pre, log_f)
    o_ml = jax.nn.sigmoid(ml_o.reshape(B, S, ML_HEADS, ML_DH).astype(f32)) * rms_norm(o_ml, ml_norm)

    return jnp.concatenate([o_dn.reshape(B, S, DN_W), o_diff.reshape(B, S, DIFF_W),
                            o_ml.reshape(B, S, ML_W)], axis=-1).astype(hn.dtype)


def swiglu(x, w_gate, w_up, w_down):
    return (jax.nn.silu(x @ w_gate) * (x @ w_up)) @ w_down


def moe_swiglu(x, router, w_gate, w_up, w_down):
    B, S, D = x.shape
    xt = x.reshape(B * S, D)
    logits = (xt @ router).astype(jnp.float32)
    top_v, top_i = lax.top_k(logits, TOP_K)
    top_w = jax.nn.softmax(top_v, axis=-1)
    gates = jnp.sum(jax.nn.one_hot(top_i, N_EXPERTS, dtype=jnp.float32) * top_w[..., None], axis=1)
    y = jnp.zeros_like(xt)
    for e in range(N_EXPERTS):
        y = y + gates[:, e:e + 1].astype(xt.dtype) * swiglu(xt, w_gate[e], w_up[e], w_down[e])
    return y.reshape(B, S, D)


def setup_inputs(seed: int = 0) -> dict:
    key = jax.random.key(seed)
    ks = iter(jax.random.split(key, 32))
    f32 = jnp.float32

    def nrm(shape, scale):
        return jax.random.normal(next(ks), shape, f32) * scale

    def gain(shape):
        return 1.0 + nrm(shape, 0.05)

    x = nrm((BATCH, SEQ, D_MODEL), 1.0)
    p = nrm((DEPTH, BATCH, SEQ, PLE_DIM), 1.0)
    attn_norm = gain((DEPTH, D_MODEL))
    w_in = nrm((DEPTH, D_MODEL, N_IN), D_MODEL ** -0.5)
    conv_dn = nrm((DEPTH, CONV_K, 3 * DN_W), CONV_K ** -0.5)
    conv_ml = nrm((DEPTH, CONV_K, 2 * ML_W), CONV_K ** -0.5)
    dn_a_log = jnp.log(jax.random.uniform(next(ks), (DEPTH, DN_HEADS), f32, 1.0, 16.0))
    dn_dt_bias = nrm((DEPTH, DN_HEADS), 0.1)
    dn_norm = gain((DEPTH, DN_DV))
    diff_lq1 = nrm((DEPTH, DIFF_DH), 0.1)
    diff_lk1 = nrm((DEPTH, DIFF_DH), 0.1)
    diff_lq2 = nrm((DEPTH, DIFF_DH), 0.1)
    diff_lk2 = nrm((DEPTH, DIFF_DH), 0.1)
    diff_norm = gain((DEPTH, DIFF_DV))
    ml_i_bias = nrm((DEPTH, ML_HEADS), 0.1)
    ml_f_bias = 3.0 + 3.0 * jax.random.uniform(next(ks), (DEPTH, ML_HEADS), f32)
    ml_norm = gain((DEPTH, ML_DH))
    w_out = nrm((DEPTH, D_MIX, D_MODEL), D_MIX ** -0.5)
    ffn_norm = gain((DEPTH, D_MODEL))
    dense_w_gate = nrm((N_DENSE, D_MODEL, D_FF), D_MODEL ** -0.5)
    dense_w_up = nrm((N_DENSE, D_MODEL, D_FF), D_MODEL ** -0.5)
    dense_w_down = nrm((N_DENSE, D_FF, D_MODEL), D_FF ** -0.5)
    router = nrm((N_MOE, D_MODEL, N_EXPERTS), D_MODEL ** -0.5)
    moe_w_gate = nrm((N_MOE, N_EXPERTS, D_MODEL, D_FF), D_MODEL ** -0.5)
    moe_w_up = nrm((N_MOE, N_EXPERTS, D_MODEL, D_FF), D_MODEL ** -0.5)
    moe_w_down = nrm((N_MOE, N_EXPERTS, D_FF, D_MODEL), D_FF ** -0.5)
    ple_norm = gain((DEPTH, D_MODEL))
    ple_proj = nrm((DEPTH, PLE_DIM, D_MODEL), PLE_DIM ** -0.5)
    ple_gate = nrm((DEPTH, D_MODEL, D_MODEL), D_MODEL ** -0.5)
    final_norm = gain((D_MODEL,))
    return {"x": x, "p": p, "attn_norm": attn_norm, "w_in": w_in, "conv_dn": conv_dn,
            "conv_ml": conv_ml, "dn_a_log": dn_a_log, "dn_dt_bias": dn_dt_bias, "dn_norm": dn_norm,
            "diff_lq1": diff_lq1, "diff_lk1": diff_lk1, "diff_lq2": diff_lq2, "diff_lk2": diff_lk2,
            "diff_norm": diff_norm, "ml_i_bias": ml_i_bias, "ml_f_bias": ml_f_bias, "ml_norm": ml_norm,
            "w_out": w_out, "ffn_norm": ffn_norm, "dense_w_gate": dense_w_gate, "dense_w_up": dense_w_up,
            "dense_w_down": dense_w_down, "router": router, "moe_w_gate": moe_w_gate,
            "moe_w_up": moe_w_up, "moe_w_down": moe_w_down, "ple_norm": ple_norm,
            "ple_proj": ple_proj, "ple_gate": ple_gate, "final_norm": final_norm}


def reference(x, p, attn_norm, w_in, conv_dn, conv_ml, dn_a_log, dn_dt_bias, dn_norm,
              diff_lq1, diff_lk1, diff_lq2, diff_lk2, diff_norm, ml_i_bias, ml_f_bias, ml_norm,
              w_out, ffn_norm, dense_w_gate, dense_w_up, dense_w_down, router, moe_w_gate,
              moe_w_up, moe_w_down, ple_norm, ple_proj, ple_gate, final_norm):
    h = x
    for i in range(DEPTH):
        lambda_init = 0.8 - 0.6 * math.exp(-0.3 * i)
        hn = rms_norm(h, attn_norm[i])
        mix = hybrid_mixer(hn, w_in[i], conv_dn[i], conv_ml[i], dn_a_log[i], dn_dt_bias[i], dn_norm[i],
                           diff_lq1[i], diff_lk1[i], diff_lq2[i], diff_lk2[i], diff_norm[i],
                           ml_i_bias[i], ml_f_bias[i], ml_norm[i], lambda_init)
        h = h + mix @ w_out[i]
        hn = rms_norm(h, ffn_norm[i])
        j = i // 2
        if i % 2 == 0:
            f = swiglu(hn, dense_w_gate[j], dense_w_up[j], dense_w_down[j])
        else:
            f = moe_swiglu(hn, router[j], moe_w_gate[j], moe_w_up[j], moe_w_down[j])
        h = h + f
        gate = jax.nn.sigmoid(rms_norm(h, ple_norm[i]) @ ple_gate[i])
        h = h + (p[i] @ ple_proj[i]) * gate
    return rms_norm(h, final_norm)
```

```cpp
#include <hip/hip_runtime.h>
#include <cstdio>
#include <cstdint>

#define DI __device__ __forceinline__
#define LAS __attribute__((address_space(3)))
#define GAS __attribute__((address_space(1)))
typedef unsigned short bf16;
typedef short bf16x8 __attribute__((ext_vector_type(8)));
typedef short s16x4 __attribute__((ext_vector_type(4)));
typedef float f32x4 __attribute__((ext_vector_type(4)));
typedef float f32x2 __attribute__((ext_vector_type(2)));
typedef unsigned u32x4 __attribute__((ext_vector_type(4)));
typedef unsigned u32x2 __attribute__((ext_vector_type(2)));

DI unsigned f2bf(float f) { unsigned u = __builtin_bit_cast(unsigned, f); return (u + 0x7fffu + ((u >> 16) & 1u)) >> 16; }
typedef __bf16 bf16x2_t __attribute__((ext_vector_type(2)));
DI unsigned pk2(float lo, float hi) { const f32x2 v = {lo, hi}; return __builtin_bit_cast(unsigned, __builtin_convertvector(v, bf16x2_t)); }
DI float bf2f(unsigned short b) { return __builtin_bit_cast(float, ((unsigned)b) << 16); }
DI float bflo(unsigned u) { return __builtin_bit_cast(float, u << 16); }
DI float bfhi(unsigned u) { return __builtin_bit_cast(float, u & 0xffff0000u); }
DI unsigned pk4_fp8(float a, float b, float c, float d) { unsigned w = 0u; w = __builtin_amdgcn_cvt_pk_fp8_f32(a, b, w, false); w = __builtin_amdgcn_cvt_pk_fp8_f32(c, d, w, true); return w; }
template <int K> DI float shx(float v) {
    if constexpr (K == 1) return __builtin_bit_cast(float, __builtin_amdgcn_update_dpp(0, __builtin_bit_cast(int, v), 0xB1, 0xF, 0xF, true));
    else if constexpr (K == 2) return __builtin_bit_cast(float, __builtin_amdgcn_update_dpp(0, __builtin_bit_cast(int, v), 0x4E, 0xF, 0xF, true));
    else if constexpr (K == 32) return __shfl_xor(v, 32);
    else return __builtin_bit_cast(float, __builtin_amdgcn_ds_swizzle(__builtin_bit_cast(int, v), (K << 10) | 0x1F));
}
DI float wave_sum(float v) { v += shx<1>(v); v += shx<2>(v); v += shx<4>(v); v += shx<8>(v); v += shx<16>(v); v += shx<32>(v); return v; }
DI float wave_max(float v) { v = fmaxf(v, shx<1>(v)); v = fmaxf(v, shx<2>(v)); v = fmaxf(v, shx<4>(v)); v = fmaxf(v, shx<8>(v)); v = fmaxf(v, shx<16>(v)); v = fmaxf(v, shx<32>(v)); return v; }
DI float sigmoidf_(float x) { return __builtin_amdgcn_rcpf(1.0f + __expf(-x)); }
DI float siluf_(float x) { return x * __builtin_amdgcn_rcpf(1.0f + __expf(-x)); }
DI float softplusf_(float x) { return fmaxf(x, 0.f) + log1pf(__expf(-fabsf(x))); }
DI void lds_barrier() { asm volatile("s_waitcnt lgkmcnt(0)" ::: "memory"); __builtin_amdgcn_s_barrier(); asm volatile("" ::: "memory"); }
#define LDS_WAIT() asm volatile("s_waitcnt lgkmcnt(0)" ::: "memory")
#define VM_WAIT() asm volatile("s_waitcnt vmcnt(0)" ::: "memory")

#define MK_SPLIT 0
namespace pg8 {
#define PG8_LAS __attribute__((address_space(3)))
typedef unsigned short bf16_t;
typedef short bf16x8 __attribute__((ext_vector_type(8)));
typedef float f32x4 __attribute__((ext_vector_type(4)));
typedef unsigned u32x4 __attribute__((ext_vector_type(4)));
constexpr int BM = 256, BK = 64, HALF = 128, HTB = HALF * BK * 2  , STAGE_BYTES = 8 * HTB, NXCD = 8, WGM = 8;

__host__ __device__ __forceinline__ int lds_byte(int r, int c) { const int st = (r >> 4) * 2 + (c >> 5), rr = r & 15, cc = c & 31, ob = rr * 64 + cc * 2; return st * 1024 + (ob ^ (((ob >> 9) & 1) << 5)); }
__host__ __device__ __forceinline__ void stage_rc(int b, int& R, int& C) { const int st = b / 1024, sb = b % 1024, swz = sb ^ (((sb >> 9) & 1) << 5); R = (st >> 1) * 16 + swz / 64; C = (st & 1) * 32 + (swz % 64) / 2; }
__host__ __device__ __forceinline__ int perm32(int rho) { const int n = rho >> 4, i = rho & 15; return 8 * (i >> 2) + 4 * n + (i & 3); }

struct Unit { int pm, pn; };
typedef int i32x8 __attribute__((ext_vector_type(8)));
struct Gemm { const bf16_t* A; const bf16_t* Bt; int M, N, K; int sa, sb; };

struct StaticOrder {
    int nM, nN, nwg, G, c;
    __host__ __device__ void init(int M, int N, int G_, int c_) { nM = M / BM; nN = N / BM; nwg = nM * nN; G = G_; c = c_; }
    __host__ __device__ bool next(int i, Unit& u) const { const int L = i * G + c; if (L >= nwg) return false; map(L, u); return true; }
    __host__ __device__ void map(int L, Unit& u) const {
        int wgid = L; { const int q = nwg / NXCD, r = nwg % NXCD, xcd = wgid % NXCD, off = wgid / NXCD; wgid = (xcd < r ? xcd * (q + 1) : r * (q + 1) + (xcd - r) * q) + off; }
        const int nig = WGM * nN, gid = wgid / nig, fm = gid * WGM, gsz = (nM - fm) < WGM ? (nM - fm) : WGM;
        u.pm = fm + ((wgid % nig) % gsz); u.pn = (wgid % nig) / gsz;
    }
    __device__ __forceinline__ size_t b_off(const Unit& u, size_t tstep) const { return (size_t)u.pn * tstep; }
    __device__ __forceinline__ void a_ready(const Unit&) const {}
    __device__ __forceinline__ void done(const Unit&) const {}
};

struct MoeOrder : StaticOrder {
    const int* tile_e; size_t estride;
    __device__ __forceinline__ size_t b_off(const Unit& u, size_t tstep) const { return (size_t)tile_e[u.pm] * estride + (size_t)u.pn * tstep; }
};
struct MoeGuOrder : MoeOrder {
    int gH, NL, H; unsigned* cnt; mutable int pend; bool lead;
    __device__ bool next(int i, Unit& u) const {
        int L; if (i < gH) L = i * G + c; else { if (c < H) return false; L = gH * G + (i - gH) * NL + (c - H); }
        if (L >= nwg) return false;
        const int ug = 8 * nN, g = L / ug, idx = L - g * ug, gsz = (nM - 8 * g) < 8 ? (nM - 8 * g) : 8, x = idx & 7, j = idx >> 3;
        u.pm = 8 * g + j % gsz; u.pn = x * (nN / 8) + j / gsz; return true; }
    __device__ __forceinline__ void done(const Unit& u) const { if (pend >= 0 && lead) __hip_atomic_fetch_add(cnt + 64 * pend, 1u, __ATOMIC_RELAXED, __HIP_MEMORY_SCOPE_AGENT); pend = u.pm; }
    __device__ __forceinline__ void flush() const { if (pend >= 0 && lead) __hip_atomic_fetch_add(cnt + 64 * pend, 1u, __ATOMIC_RELAXED, __HIP_MEMORY_SCOPE_AGENT); pend = -1; }
};
struct MoeDnOrder : MoeOrder {
    const unsigned* cnt; unsigned need;
    __device__ bool next(int i, Unit& u) const {
        const int L = i * G + c; if (L >= nwg) return false;
        const int ub = 32 * nN, band = L / ub, idx = L - band * ub, rows = (nM - 32 * band) < 32 ? (nM - 32 * band) : 32;
        if (rows == 32) { const int x = idx & 7, k = idx >> 3; u.pm = 32 * band + 8 * (x >> 1) + (k & 7); u.pn = (nN / 2) * (x & 1) + (k >> 3); }
        else { u.pm = 32 * band + idx / nN; u.pn = idx % nN; }
        return true; }
    __device__ __forceinline__ void a_ready(const Unit& u) const {
        unsigned* p = (unsigned*)cnt + 64 * u.pm; unsigned sp = 0;
        while ((unsigned)__builtin_amdgcn_readfirstlane((int)__hip_atomic_load(p, __ATOMIC_RELAXED, __HIP_MEMORY_SCOPE_AGENT)) < need) { __builtin_amdgcn_s_sleep(1); if (++sp > (1u << 21)) break; }
        __builtin_amdgcn_fence(__ATOMIC_ACQUIRE, "agent"); }
};
typedef float f32x2_ __attribute__((ext_vector_type(2))); typedef __bf16 bf16x2_ __attribute__((ext_vector_type(2)));
__device__ __forceinline__ unsigned cvt_pk_bf16(float lo, float hi) { const f32x2_ v = {lo, hi}; return __builtin_bit_cast(unsigned, __builtin_convertvector(v, bf16x2_)); }
struct EpiBf16Plain {
    static constexpr bool PERM = true, AFTER_DRAIN = false;
    bf16_t* O; int ldc;
    __device__ __forceinline__ void operator()(const f32x4 (&acc)[2][2][4][2], const Unit& u, int wr, int wc, int fr, int fq) const {
        const int row0 = u.pm * BM + wr * 64 + fr, col0 = u.pn * BM + wc * 32 + 8 * fq;
#pragma unroll
        for (int ai = 0; ai < 2; ++ai)
#pragma unroll
            for (int m = 0; m < 4; ++m) { bf16_t* rowp = O + (size_t)(row0 + ai * HALF + m * 16) * ldc + col0;
#pragma unroll
                for (int bj = 0; bj < 2; ++bj) { const f32x4 v0 = acc[ai][bj][m][0], v1 = acc[ai][bj][m][1];
                    u32x4 w; w.x = cvt_pk_bf16(v0[0], v0[1]); w.y = cvt_pk_bf16(v0[2], v0[3]); w.z = cvt_pk_bf16(v1[0], v1[1]); w.w = cvt_pk_bf16(v1[2], v1[3]);
                    *(u32x4*)(rowp + bj * HALF) = w; } }
    }
};
template <bool OUT8, bool WT = false  > struct EpiSwiGLU {
    static constexpr bool PERM = true, AFTER_DRAIN = false;
    unsigned char* O; int ldc; float oscale;
    __device__ __forceinline__ void operator()(const f32x4 (&acc)[2][2][4][2], const Unit& u, int wr, int wc, int fr, int fq) const {
        const int row0 = u.pm * BM + wr * 64 + fr, col0 = u.pn * HALF + wc * 32 + 8 * fq;
        if constexpr (WT) {
            static_assert(OUT8, "write-through variant is fp8 only");
            const bool odd = fq & 1;
#pragma unroll
            for (int ai = 0; ai < 2; ++ai)
#pragma unroll
                for (int mp = 0; mp < 4; mp += 2) { unsigned w[2][2];
#pragma unroll
                    for (int mm = 0; mm < 2; ++mm) { float r[8];
#pragma unroll
                        for (int n = 0; n < 2; ++n)
#pragma unroll
                            for (int j = 0; j < 4; ++j) { const float g = acc[ai][0][mp + mm][n][j], up = acc[ai][1][mp + mm][n][j];
                                r[n * 4 + j] = __builtin_amdgcn_fmed3f(g * __builtin_amdgcn_rcpf(1.0f + __expf(-g)) * (up * oscale), -448.0f, 448.0f); }
                        unsigned w0 = 0u, w1 = 0u;
                        w0 = __builtin_amdgcn_cvt_pk_fp8_f32(r[0], r[1], w0, false); w0 = __builtin_amdgcn_cvt_pk_fp8_f32(r[2], r[3], w0, true);
                        w1 = __builtin_amdgcn_cvt_pk_fp8_f32(r[4], r[5], w1, false); w1 = __builtin_amdgcn_cvt_pk_fp8_f32(r[6], r[7], w1, true);
                        w[mm][0] = w0; w[mm][1] = w1; }
                    const unsigned sx = odd ? w[0][0] : w[1][0], sy = odd ? w[0][1] : w[1][1];
                    const unsigned rx = (unsigned)__builtin_amdgcn_ds_swizzle((int)sx, (16 << 10) | 0x1F), ry = (unsigned)__builtin_amdgcn_ds_swizzle((int)sy, (16 << 10) | 0x1F);
                    u32x4 o; o.x = odd ? rx : w[0][0]; o.y = odd ? ry : w[0][1]; o.z = odd ? w[1][0] : rx; o.w = odd ? w[1][1] : ry;
                    unsigned char* p = O + (size_t)(row0 + ai * HALF + (mp + (odd ? 1 : 0)) * 16) * ldc + (col0 - (odd ? 8 : 0));
                    asm volatile("global_store_dwordx4 %0, %1, off sc1\n\ts_nop 1" :: "v"(p), "v"(o) : "memory"); }
            return; }
#pragma unroll
        for (int ai = 0; ai < 2; ++ai)
#pragma unroll
            for (int m = 0; m < 4; ++m) { unsigned char* rowp = O + ((size_t)(row0 + ai * HALF + m * 16) * ldc + col0) * (OUT8 ? 1 : 2);
                float r[8];
#pragma unroll
                for (int n = 0; n < 2; ++n)
#pragma unroll
                    for (int j = 0; j < 4; ++j) { const float g = acc[ai][0][m][n][j], up = acc[ai][1][m][n][j]; float t = g * __builtin_amdgcn_rcpf(1.0f + __expf(-g)) * (OUT8 ? up * oscale : up); if (OUT8) t = __builtin_amdgcn_fmed3f(t, -448.0f, 448.0f);
                        r[n * 4 + j] = t; }
                if constexpr (OUT8) { unsigned w0 = 0u, w1 = 0u;
                    w0 = __builtin_amdgcn_cvt_pk_fp8_f32(r[0], r[1], w0, false); w0 = __builtin_amdgcn_cvt_pk_fp8_f32(r[2], r[3], w0, true);
                    w1 = __builtin_amdgcn_cvt_pk_fp8_f32(r[4], r[5], w1, false); w1 = __builtin_amdgcn_cvt_pk_fp8_f32(r[6], r[7], w1, true);
                    *(unsigned long long*)rowp = (unsigned long long)w0 | ((unsigned long long)w1 << 32); }
                else { u32x4 w; w.x = cvt_pk_bf16(r[0], r[1]); w.y = cvt_pk_bf16(r[2], r[3]); w.z = cvt_pk_bf16(r[4], r[5]); w.w = cvt_pk_bf16(r[6], r[7]); *(u32x4*)rowp = w; } }
    }
};
template <int MODE, bool RF32> struct EpiRes {
    static constexpr bool PERM = true, AFTER_DRAIN = false;
    bf16_t* C; const void* R; const bf16_t* P; int ld;
    static __device__ __forceinline__ float lo_(unsigned u) { return __builtin_bit_cast(float, u << 16); }
    static __device__ __forceinline__ float hi_(unsigned u) { return __builtin_bit_cast(float, u & 0xffff0000u); }
    __device__ __forceinline__ void operator()(const f32x4 (&acc)[2][2][4][2], const Unit& u, int wr, int wc, int fr, int fq) const {
        const int row0 = u.pm * BM + wr * 64 + fr, col0 = u.pn * BM + wc * 32 + 8 * fq;
        constexpr int MB = (MODE == 2 || RF32) ? 2 : 4;
#pragma unroll
        for (int ai = 0; ai < 2; ++ai)
#pragma unroll
            for (int m0 = 0; m0 < 4; m0 += MB) {
                u32x4 rb[MB][2], pb[MB][2]; f32x4 rf[MB][2][2];
#pragma unroll
                for (int mm = 0; mm < MB; ++mm)
#pragma unroll
                    for (int bj = 0; bj < 2; ++bj) { const size_t off = (size_t)(row0 + ai * HALF + (m0 + mm) * 16) * ld + col0 + bj * HALF;
                        if constexpr (RF32) { rf[mm][bj][0] = *(const f32x4*)((const float*)R + off); rf[mm][bj][1] = *(const f32x4*)((const float*)R + off + 4); }
                        else rb[mm][bj] = *(const u32x4*)((const bf16_t*)R + off);
                        if constexpr (MODE == 2) pb[mm][bj] = *(const u32x4*)(P + off); }
#pragma unroll
                for (int mm = 0; mm < MB; ++mm)
#pragma unroll
                    for (int bj = 0; bj < 2; ++bj) { const size_t off = (size_t)(row0 + ai * HALF + (m0 + mm) * 16) * ld + col0 + bj * HALF;
                        f32x4 r0, r1;
                        if constexpr (RF32) { r0 = rf[mm][bj][0]; r1 = rf[mm][bj][1]; }
                        else { const u32x4 w = rb[mm][bj]; r0 = (f32x4){lo_(w.x), hi_(w.x), lo_(w.y), hi_(w.y)}; r1 = (f32x4){lo_(w.z), hi_(w.z), lo_(w.w), hi_(w.w)}; }
                        f32x4 v0 = acc[ai][bj][m0 + mm][0], v1 = acc[ai][bj][m0 + mm][1];
                        if constexpr (MODE == 2) { const u32x4 w = pb[mm][bj]; const f32x4 p0 = {lo_(w.x), hi_(w.x), lo_(w.y), hi_(w.y)}, p1 = {lo_(w.z), hi_(w.z), lo_(w.w), hi_(w.w)};
#pragma unroll
                            for (int j = 0; j < 4; ++j) { v0[j] = p0[j] * __builtin_amdgcn_rcpf(1.0f + __expf(-v0[j])); v1[j] = p1[j] * __builtin_amdgcn_rcpf(1.0f + __expf(-v1[j])); } }
                        v0 = v0 + r0; v1 = v1 + r1;
                        u32x4 o; o.x = cvt_pk_bf16(v0[0], v0[1]); o.y = cvt_pk_bf16(v0[2], v0[3]); o.z = cvt_pk_bf16(v1[0], v1[1]); o.w = cvt_pk_bf16(v1[2], v1[3]);
                        *(u32x4*)(C + off) = o; }
                asm volatile("" ::: "memory"); }
    }
};
template <int MODE  > struct EpiF32 {
    static constexpr bool PERM = false, AFTER_DRAIN = false;
    float* C; const float* R; const float* P; int ldc, ldr, ldp;
    __device__ __forceinline__ void operator()(const f32x4 (&acc)[2][2][4][2], const Unit& u, int wr, int wc, int fr, int fq) const {
        const int row0 = u.pm * BM + wr * 64 + fr, col0 = u.pn * BM + wc * 32 + 4 * fq;
        constexpr int MB = (MODE == 2) ? 2 : 4;
#pragma unroll
        for (int ai = 0; ai < 2; ++ai)
#pragma unroll
            for (int m0 = 0; m0 < 4; m0 += MB) {
                f32x4 rv[MB][4], pv[MB][4];
                if (MODE >= 1) {
#pragma unroll
                    for (int mm = 0; mm < MB; ++mm) { const size_t rr = (size_t)(row0 + ai * HALF + (m0 + mm) * 16) * ldr + col0, rp = (size_t)(row0 + ai * HALF + (m0 + mm) * 16) * ldp + col0;
#pragma unroll
                        for (int q = 0; q < 4; ++q) { rv[mm][q] = *(const f32x4*)(R + rr + (q >> 1) * HALF + (q & 1) * 16); if (MODE == 2) pv[mm][q] = *(const f32x4*)(P + rp + (q >> 1) * HALF + (q & 1) * 16); } } }
#pragma unroll
                for (int mm = 0; mm < MB; ++mm) { const int m = m0 + mm; const size_t ro = (size_t)(row0 + ai * HALF + m * 16) * ldc + col0;
#pragma unroll
                    for (int q = 0; q < 4; ++q) { f32x4 v = acc[ai][q >> 1][m][q & 1];
                        if (MODE == 1) v = v + rv[mm][q];
                        if (MODE == 2) { f32x4 s;
#pragma unroll
                            for (int j = 0; j < 4; ++j) s[j] = pv[mm][q][j] * __builtin_amdgcn_rcpf(1.0f + __expf(-v[j]));
                            v = rv[mm][q] + s; }
                        *(f32x4*)(C + ro + (q >> 1) * HALF + (q & 1) * 16) = v; } }
                asm volatile("" ::: "memory"); }
    }
};


template <class Epi, class Sched, bool ALIGN_EPI = false, bool SP2 = false, bool F8 = false  >
__device__ __forceinline__ void gemm_phase(PG8_LAS unsigned char* lds, const Gemm g, const Sched& S, const Epi& E, const int wid_  ) {
    int tid = __builtin_amdgcn_mbcnt_hi(~0u, __builtin_amdgcn_mbcnt_lo(~0u, 0u)); asm volatile("" : "+v"(tid)); tid += wid_ * 64;
    const int wid = __builtin_amdgcn_readfirstlane(tid >> 6), lane = tid & 63, wr = wid >> 2, wc = wid & 3, fr = lane & 15, fq = lane >> 4;
    const int K = g.K, nt = K / BK;
    unsigned voffA[2], voffB[2];
#pragma unroll
    for (int i = 0; i < 2; ++i) { int R, C; stage_rc(tid * 16 + i * 8192, R, C); const int Rb = Epi::PERM ? ((R & ~31) + perm32(R & 31)) : R;
        voffA[i] = (unsigned)(R * K + C) * 2u; voffB[i] = (unsigned)(Rb * K + C) * 2u; }
    const unsigned kstep = (unsigned)(BK * 2);
    const unsigned hstep = (unsigned)HALF * (unsigned)K * 2u;
    const unsigned tstep = 2u * hstep;
    const unsigned ldsw = (unsigned)wid * 1024u;
    const int aoff = lds_byte(wr * 64 + fr, fq * 8), boff = lds_byte(wc * 32 + fr, fq * 8);
#define PG8_SA(b, h) (((b) * 2 + (h)) * HTB)
#define PG8_SB(b, h) ((4 + (b) * 2 + (h)) * HTB)
    const __amdgpu_buffer_rsrc_t rsrc_voffA = __builtin_amdgcn_make_buffer_rsrc((void*)g.A, 0, 0xFFFFFFFF, 0x00020000), rsrc_voffB = __builtin_amdgcn_make_buffer_rsrc((void*)g.Bt, 0, 0xFFFFFFFF, 0x00020000);
#define PG8_STAGE(bufoff, goff, voff) do { _Pragma("unroll") for (int _i = 0; _i < 2; ++_i) \
        __builtin_amdgcn_raw_ptr_buffer_load_lds(rsrc_##voff, (PG8_LAS unsigned*)(lds + (bufoff) + ldsw + _i * 8192), 16, (int)(voff)[_i], (int)(goff), 0, 0); } while (0)
#define PG8_LDA(dst, b, h) do { _Pragma("unroll") for (int m = 0; m < 4; ++m) _Pragma("unroll") for (int k = 0; k < 2; ++k) dst[m][k] = *(const PG8_LAS bf16x8*)(lds + PG8_SA(b, h) + aoff + m * 2048 + k * 1024); } while (0)
#define PG8_LDB(dst, b, h) do { _Pragma("unroll") for (int n = 0; n < 2; ++n) _Pragma("unroll") for (int k = 0; k < 2; ++k) dst[n][k] = *(const PG8_LAS bf16x8*)(lds + PG8_SB(b, h) + boff + n * 2048 + k * 1024); } while (0)
#define PG8_MMA(ai, bj, At, Bt) do { __builtin_amdgcn_s_setprio(1); _Pragma("unroll") for (int m = 0; m < 4; ++m) _Pragma("unroll") for (int n = 0; n < 2; ++n) { \
        if constexpr (F8) { const i32x8 a8_ = __builtin_bit_cast(i32x8, __builtin_shufflevector(At[m][0], At[m][1], 0, 1, 2, 3, 4, 5, 6, 7, 8, 9, 10, 11, 12, 13, 14, 15)); \
            const i32x8 b8_ = __builtin_bit_cast(i32x8, __builtin_shufflevector(Bt[n][0], Bt[n][1], 0, 1, 2, 3, 4, 5, 6, 7, 8, 9, 10, 11, 12, 13, 14, 15)); \
            acc[ai][bj][m][n] = __builtin_amdgcn_mfma_scale_f32_16x16x128_f8f6f4(b8_, a8_, acc[ai][bj][m][n], 0, 0, 0, g.sb, 0, g.sa); } \
        else { _Pragma("unroll") for (int k = 0; k < 2; ++k) acc[ai][bj][m][n] = __builtin_amdgcn_mfma_f32_16x16x32_bf16(Bt[n][k], At[m][k], acc[ai][bj][m][n], 0, 0, 0); } } \
        __builtin_amdgcn_s_setprio(0); } while (0)
#define PG8_WAIT_V(n) asm volatile("s_waitcnt vmcnt(" #n ")" ::: "memory")
#define PG8_WAIT_L(n) asm volatile("s_waitcnt lgkmcnt(" #n ")" ::: "memory")
#define PG8_BAR __builtin_amdgcn_s_barrier()
#define PG8_SCHED __builtin_amdgcn_sched_barrier(0)
    Unit cur, nxt; int ui = 0;
    if (!S.next(0, cur)) return;
    f32x4 acc[2][2][4][2];
#pragma unroll
    for (int a = 0; a < 2; ++a)
#pragma unroll
        for (int b = 0; b < 2; ++b)
#pragma unroll
            for (int m = 0; m < 4; ++m)
#pragma unroll
                for (int n = 0; n < 2; ++n) acc[a][b][m][n] = (f32x4){0.f, 0.f, 0.f, 0.f};
    bf16x8 At[4][2], B0[2][2], B1[2][2];
    unsigned cA = (unsigned)cur.pm * tstep, cB = (unsigned)S.b_off(cur, tstep);
    S.a_ready(cur);
    if constexpr (SP2) {
        PG8_STAGE(PG8_SB(0, 0), cB, voffB); PG8_STAGE(PG8_SB(0, 1), cB + hstep, voffB); PG8_STAGE(PG8_SA(0, 0), cA, voffA); PG8_STAGE(PG8_SA(0, 1), cA + hstep, voffA);
        if (wr == 1) PG8_BAR;
        PG8_WAIT_V(2); PG8_BAR;
        PG8_STAGE(PG8_SB(1, 0), cB + kstep, voffB); PG8_STAGE(PG8_SA(1, 0), cA + kstep, voffA); PG8_STAGE(PG8_SB(1, 1), cB + hstep + kstep, voffB);
        PG8_WAIT_V(6); PG8_BAR;
    } else {
        PG8_STAGE(PG8_SB(0, 0), cB, voffB); PG8_STAGE(PG8_SA(0, 0), cA, voffA); PG8_STAGE(PG8_SB(0, 1), cB + hstep, voffB); PG8_STAGE(PG8_SA(0, 1), cA + hstep, voffA);
        if (wr == 1) PG8_BAR;
        PG8_WAIT_V(4); PG8_BAR;
        PG8_STAGE(PG8_SB(1, 0), cB + kstep, voffB); PG8_STAGE(PG8_SA(1, 0), cA + kstep, voffA); PG8_STAGE(PG8_SB(1, 1), cB + hstep + kstep, voffB);
        PG8_WAIT_V(6); PG8_BAR;
    }
    for (;;) {
        const bool has_next = S.next(ui + 1, nxt);
        const unsigned nA = has_next ? (unsigned)nxt.pm * tstep : cA, nB = has_next ? (unsigned)S.b_off(nxt, tstep) : cB;
        for (int t = 0; t < nt; t += 2) {
            const bool last = (t == nt - 2);
            const unsigned a1 = cA + (unsigned)(t + 1) * kstep;
            const unsigned a2 = last ? nA : cA + (unsigned)(t + 2) * kstep, b2 = last ? nB : cB + (unsigned)(t + 2) * kstep;
            const unsigned a3 = a2 + kstep, b3 = b2 + kstep;
            if (last && has_next) S.a_ready(nxt);
            if constexpr (SP2) {
            PG8_LDB(B0, 0, 0); PG8_LDB(B1, 0, 1); PG8_SCHED; PG8_LDA(At, 0, 0); PG8_STAGE(PG8_SA(1, 1), a1 + hstep, voffA);
            PG8_WAIT_V(8); PG8_WAIT_L(0); PG8_BAR; PG8_MMA(0, 0, At, B0); PG8_MMA(0, 1, At, B1); PG8_BAR; PG8_SCHED;
            PG8_LDA(At, 0, 1); PG8_STAGE(PG8_SB(0, 0), b2, voffB); PG8_STAGE(PG8_SB(0, 1), b2 + hstep, voffB); PG8_STAGE(PG8_SA(0, 0), a2, voffA);
            PG8_WAIT_V(8); PG8_WAIT_L(0); PG8_BAR; PG8_MMA(1, 0, At, B0); PG8_MMA(1, 1, At, B1); PG8_BAR; PG8_SCHED;
            PG8_LDB(B0, 1, 0); PG8_LDB(B1, 1, 1); PG8_SCHED; PG8_LDA(At, 1, 0); PG8_STAGE(PG8_SA(0, 1), a2 + hstep, voffA);
            PG8_WAIT_V(8); PG8_WAIT_L(0); PG8_BAR; PG8_MMA(0, 0, At, B0); PG8_MMA(0, 1, At, B1); PG8_BAR; PG8_SCHED;
            PG8_LDA(At, 1, 1); PG8_STAGE(PG8_SB(1, 0), b3, voffB); PG8_STAGE(PG8_SB(1, 1), b3 + hstep, voffB); PG8_STAGE(PG8_SA(1, 0), a3, voffA);
            PG8_WAIT_V(8); PG8_WAIT_L(0); PG8_BAR; PG8_MMA(1, 0, At, B0); PG8_MMA(1, 1, At, B1); PG8_BAR; PG8_SCHED;
            } else {
            PG8_LDB(B0, 0, 0); PG8_SCHED; PG8_LDA(At, 0, 0); PG8_STAGE(PG8_SA(1, 1), a1 + hstep, voffA);
            PG8_WAIT_L(8); PG8_BAR; PG8_WAIT_L(0); PG8_MMA(0, 0, At, B0); PG8_BAR; PG8_SCHED;
            PG8_LDB(B1, 0, 1); PG8_STAGE(PG8_SB(0, 0), b2, voffB);
            PG8_BAR; PG8_WAIT_L(0); PG8_MMA(0, 1, At, B1); PG8_BAR;
            PG8_LDA(At, 0, 1); PG8_STAGE(PG8_SA(0, 0), a2, voffA);
            PG8_BAR; PG8_WAIT_L(0); PG8_MMA(1, 0, At, B0); PG8_BAR; PG8_SCHED;
            PG8_STAGE(PG8_SB(0, 1), b2 + hstep, voffB);
            PG8_WAIT_V(6); PG8_BAR; PG8_MMA(1, 1, At, B1); PG8_BAR;
            PG8_LDB(B0, 1, 0); PG8_SCHED; PG8_LDA(At, 1, 0); PG8_STAGE(PG8_SA(0, 1), a2 + hstep, voffA);
            PG8_WAIT_L(8); PG8_BAR; PG8_WAIT_L(0); PG8_MMA(0, 0, At, B0); PG8_BAR; PG8_SCHED;
            PG8_LDB(B1, 1, 1); PG8_STAGE(PG8_SB(1, 0), b3, voffB);
            PG8_BAR; PG8_WAIT_L(0); PG8_MMA(0, 1, At, B1); PG8_BAR;
            PG8_LDA(At, 1, 1); PG8_STAGE(PG8_SA(1, 0), a3, voffA);
            PG8_BAR; PG8_WAIT_L(0); PG8_MMA(1, 0, At, B0); PG8_BAR; PG8_SCHED;
            PG8_STAGE(PG8_SB(1, 1), b3 + hstep, voffB);
            PG8_WAIT_V(6); PG8_BAR; PG8_MMA(1, 1, At, B1); PG8_BAR;
            }
        }
        if constexpr (ALIGN_EPI) { if (wr == 0) PG8_BAR; }
        if constexpr (!Epi::AFTER_DRAIN) { int le_ = __builtin_amdgcn_mbcnt_hi(~0u, __builtin_amdgcn_mbcnt_lo(~0u, 0u)); asm volatile("" : "+v"(le_));
            E(acc, cur, wr, wc, le_ & 15, le_ >> 4); S.done(cur); }
        if (!has_next) break;
#pragma unroll
        for (int a = 0; a < 2; ++a)
#pragma unroll
            for (int b = 0; b < 2; ++b)
#pragma unroll
                for (int m = 0; m < 4; ++m)
#pragma unroll
                    for (int n = 0; n < 2; ++n) acc[a][b][m][n] = (f32x4){0.f, 0.f, 0.f, 0.f};
        cur = nxt; cA = nA; cB = nB; ++ui;
        if constexpr (ALIGN_EPI) { if (wr == 1) PG8_BAR; }
    }
    PG8_WAIT_V(0);
    if constexpr (!ALIGN_EPI) { if (wr == 0) PG8_BAR; }
    PG8_BAR;
    if constexpr (Epi::AFTER_DRAIN) { E.fused(acc, cur, wr, wc, fr, fq, lds, wid, lane); S.done(cur); }
#undef PG8_SA
#undef PG8_SB
#undef PG8_STAGE
#undef PG8_LDA
#undef PG8_LDB
#undef PG8_MMA
#undef PG8_WAIT_V
#undef PG8_WAIT_L
#undef PG8_BAR
#undef PG8_SCHED
}
}
#define XB_TMO      128
#define XB_XCNT(j)  (256  + 64 * (j))
#define XB_XSUB(j)  (1280 + 64 * (j))
#define XB_XGEN(j)  (2304 + 64 * (j))
#define XB_TOP      3328
#define XB_TOPGEN   3392
#define XCD_BAR_WORDS 3456
#define XB_SPIN_CAP (1u << 18)

__device__ __forceinline__ unsigned xb_ld(unsigned* p)              { return __hip_atomic_load(p, __ATOMIC_RELAXED, __HIP_MEMORY_SCOPE_AGENT); }
__device__ __forceinline__ unsigned xb_add(unsigned* p, unsigned v) { return __hip_atomic_fetch_add(p, v, __ATOMIC_RELAXED, __HIP_MEMORY_SCOPE_AGENT); }
__device__ __forceinline__ unsigned xb_xcc_id() { return (unsigned)__builtin_amdgcn_s_getreg((3 << 11) | 20) & 0xFu; }
#define XB_SPIN(cond, bar) do { unsigned _sp = 0; while (cond) { __builtin_amdgcn_s_sleep(1); \
    if ((++_sp & 255u) == 0u) { if (xb_ld(&(bar)[XB_TMO])) break; if (_sp > XB_SPIN_CAP) { atomicAdd(&(bar)[XB_TMO], 1u); break; } } } } while (0)

struct XcdBarrier {
    unsigned* bar; unsigned x;
    volatile LAS unsigned* st;
};

__device__ __forceinline__ XcdBarrier xcd_barrier_post(unsigned* bar, volatile LAS unsigned* st) {
    XcdBarrier b; b.bar = bar; b.x = xb_xcc_id(); b.st = st;
    if (threadIdx.x == 0) (void)xb_add(&bar[XB_XCNT(b.x)], 1u);
    return b;
}
__device__ __forceinline__ void xcd_barrier_complete(unsigned* bar, unsigned x, unsigned& nloc, unsigned& nx) {
    const unsigned G = gridDim.x * gridDim.y * gridDim.z;
    unsigned sum, cnt, mine, sp = 0u;
    for (;;) {
        sum = 0u; cnt = 0u; mine = 0u;
#pragma unroll
        for (unsigned j = 0; j < 16; ++j) { const unsigned c = xb_ld(&bar[XB_XCNT(j)]); sum += c; cnt += (c > 0u) ? 1u : 0u; mine = (j == x) ? c : mine; }
        if (sum == G) break;
        __builtin_amdgcn_s_sleep(1);
        if ((++sp & 255u) == 0u) { if (xb_ld(&bar[XB_TMO])) break; if (sp > XB_SPIN_CAP) { atomicAdd(&bar[XB_TMO], 1u); break; } }
    }
    nloc = mine > 0u ? mine : 1u; nx = cnt > 0u ? cnt : 1u;
}

__device__ __forceinline__ void xcd_barrier(const XcdBarrier& b) {
    asm volatile("s_waitcnt vmcnt(0)" ::: "memory");
    __syncthreads();
    if (threadIdx.x == 0) {
        unsigned* bar = b.bar;
        __builtin_amdgcn_s_waitcnt(0);
        unsigned nloc = b.st[0], nx = b.st[1];
        if (nloc == 0u) { xcd_barrier_complete(bar, b.x, nloc, nx); b.st[0] = nloc; b.st[1] = nx; }
        const unsigned old = xb_add(&bar[XB_XSUB(b.x)], 1u);
        const unsigned gen = old / nloc;
        if (old + 1u == (gen + 1u) * nloc) {
            __builtin_amdgcn_fence(__ATOMIC_RELEASE, "agent");
            asm volatile("s_waitcnt vmcnt(0)" ::: "memory");
            const unsigned og = xb_add(&bar[XB_TOP], 1u);
            const unsigned tg = og / nx;
            if (og + 1u == (tg + 1u) * nx) xb_add(&bar[XB_TOPGEN], 1u);
            else XB_SPIN(xb_ld(&bar[XB_TOPGEN]) == tg, bar);
            __builtin_amdgcn_fence(__ATOMIC_ACQUIRE, "agent");
            xb_add(&bar[XB_XGEN(b.x)], 1u);
            asm volatile("s_waitcnt vmcnt(0)" ::: "memory");
        } else {
            XB_SPIN(xb_ld(&bar[XB_XGEN(b.x)]) == gen, bar);
            __builtin_amdgcn_fence(__ATOMIC_ACQUIRE, "agent");
            asm volatile("s_waitcnt vmcnt(0)" ::: "memory");
        }
    }
    __syncthreads();
}

constexpr int NWAVES = 8, NTHR = 512, GRID = 256;
constexpr int M = 16384, D = 2048, SEQ = 2048, NBATCH = 8, NZ = 7168, NIN = 7184, DFF = 7168, NEXP = 8, PLE = 256;
constexpr int NCHUNK = 1024;
constexpr int NCONV = 118;
constexpr float EPS = 1e-6f;
constexpr int LS_HN = 2, LS_WGU = 5, LS_ACT = 3, LS_WD = 6;
constexpr int SB(int l) { return (127 - l) * 0x01010101; }
constexpr int MAXPT = 136;
constexpr size_t MiB = 1u << 20;
constexpr size_t WS_CTL = 0, CTL_ZERO_BYTES = 1 * MiB;
constexpr size_t WS_WGT = 1 * MiB;
constexpr size_t WS_WRT = WS_WGT + 256 * 1024;
constexpr size_t WS_GD = 2 * MiB, WS_MLS = 3 * MiB, WS_MLCS = 5 * MiB  , WS_DNGL = 5 * MiB + 16384;
constexpr size_t WS_TOPE = 6 * MiB, WS_TOPW = WS_TOPE + 128 * 1024, WS_SLOT = WS_TOPW + 128 * 1024, WS_BLKCNT = WS_SLOT + 128 * 1024, WS_TILEE = WS_BLKCNT + 64 * 1024;
constexpr size_t WS_WIN = 8 * MiB, WS_WOUT = 64 * MiB, WS_WGU = 80 * MiB, WS_WD = 136 * MiB, WS_WPG = 164 * MiB, WS_WPP = 180 * MiB, WS_MGU = 182 * MiB, WS_MD = 630 * MiB;
constexpr size_t WS_H = 854 * MiB, WS_HN = 982 * MiB, WS_T = 1046 * MiB, WS_END = (1046 + 748) * MiB;
constexpr size_t T_Z = 0, T_ZC = 224 * MiB, T_U = 304 * MiB, T_W = 336 * MiB, T_QG = 368 * MiB, T_KGT = 384 * MiB, T_ATT = 400 * MiB, T_DCT = 408 * MiB, T_CST = 474 * MiB, T_MIX = 510 * MiB;
constexpr size_t T_ACT = 0, T_APERM = 476 * MiB, T_YPERM = 612 * MiB, T_PB = 0, T_PP = 16 * MiB;
constexpr int CW_TMO = 0;
constexpr int CW_QUEUE = 2048;
constexpr int CW_MOECNT = 16384;
constexpr int CW_BAR = 4096;
constexpr int RING_BYTES = 131072;
constexpr int MISC_OFF = 139264;
constexpr int LDS_BYTES = 147456;


struct Params { const float* in[30]; float* out; unsigned char* ws; int ph_lo, ph_hi; };
enum { I_X = 0, I_P, I_ATTN_NORM, I_W_IN, I_CONV_DN, I_CONV_ML, I_DN_A_LOG, I_DN_DT_BIAS, I_DN_NORM, I_LQ1, I_LK1, I_LQ2, I_LK2, I_DIFF_NORM, I_ML_I_BIAS, I_ML_F_BIAS, I_ML_NORM,
       I_W_OUT, I_FFN_NORM, I_DG, I_DU, I_DD, I_ROUTER, I_MG, I_MU, I_MD, I_PLE_NORM, I_PLE_PROJ, I_PLE_GATE, I_FINAL_NORM };
struct Frame { LAS unsigned char* lds; volatile LAS unsigned* MISC; int tid, lane, wave, G, bid; };

DI float wave_incl_sum(float v, int lane) {
#pragma unroll
    for (int o = 1; o < 64; o <<= 1) { const float t = __shfl_up(v, o); if (lane >= o) v += t; }
    return v;
}
DI float wave_incl_max(float v, int lane) {
#pragma unroll
    for (int o = 1; o < 64; o <<= 1) { const float t = __shfl_up(v, o); if (lane >= o) v = fmaxf(v, t); }
    return v;
}
DI bf16x8 frag_row(const LAS unsigned char* base, int RS, int r0, int k0, int lane) { return *(const LAS bf16x8*)(base + (r0 + (lane & 15)) * RS + (k0 + 8 * (lane >> 4)) * 2); }
DI bf16x8 frag_tr2(unsigned base_addr, int RS, int rowA, int rowB, int c0, int lane) {
    const int q = (lane & 15) >> 2, p = lane & 3;
    const unsigned a0 = base_addr + (unsigned)((rowA + q) * RS + (c0 + 4 * p) * 2), a1 = base_addr + (unsigned)((rowB + q) * RS + (c0 + 4 * p) * 2);
    s16x4 x, y;
    asm volatile("ds_read_b64_tr_b16 %0, %2\n\tds_read_b64_tr_b16 %1, %3\n\ts_waitcnt lgkmcnt(0)" : "=&v"(x), "=&v"(y) : "v"(a0), "v"(a1) : "memory");
    bf16x8 r; r[0] = x[0]; r[1] = x[1]; r[2] = x[2]; r[3] = x[3]; r[4] = y[0]; r[5] = y[1]; r[6] = y[2]; r[7] = y[3]; return r;
}
DI bf16x8 frag_tr(unsigned base_addr, int RS, int k0, int c0, int lane) { const int g = lane >> 4; return frag_tr2(base_addr, RS, k0 + 8 * g, k0 + 8 * g + 4, c0, lane); }
#define MFMA16(a, b, c) __builtin_amdgcn_mfma_f32_16x16x32_bf16((a), (b), (c), 0, 0, 0)

template <bool F8> DI void tr_tile(const float* __restrict__ W, int ldn, int K, int k0, int nsrc0, unsigned char* __restrict__ WT, int ndst0, LAS unsigned char* scr, int lane, float wscale) {
    const int r = lane >> 4, c4 = lane & 15;
    f32x4 v[16];
#pragma unroll
    for (int i = 0; i < 16; ++i) v[i] = __builtin_nontemporal_load((const f32x4*)(W + (size_t)(k0 + 4 * i + r) * ldn + nsrc0 + 4 * c4));
#pragma unroll
    for (int i = 0; i < 16; ++i) { const f32x4 x = F8 ? v[i] * wscale : v[i];
        *(LAS unsigned long long*)(scr + (4 * i + r) * 144 + c4 * 8) = (unsigned long long)pk2(x[0], x[1]) | ((unsigned long long)pk2(x[2], x[3]) << 32); }
    LDS_WAIT();
    const int g = lane >> 4, j = lane & 15, q = j >> 2, pp = j & 3;
    if constexpr (F8) {
        const unsigned base = (unsigned)(size_t)scr + (unsigned)((16 * g + q) * 144 + pp * 8);
#pragma unroll
        for (int nb = 0; nb < 4; ++nb) {
            s16x4 l0, h0, l1, h1; const unsigned a0 = base + (unsigned)(32 * nb);
            asm volatile("ds_read_b64_tr_b16 %0, %4\n\tds_read_b64_tr_b16 %1, %4 offset:576\n\tds_read_b64_tr_b16 %2, %4 offset:1152\n\tds_read_b64_tr_b16 %3, %4 offset:1728\n\ts_waitcnt lgkmcnt(0)" : "=&v"(l0), "=&v"(h0), "=&v"(l1), "=&v"(h1) : "v"(a0) : "memory");
            const size_t n = (size_t)(ndst0 + 16 * nb + j); const int kk = k0 + 16 * g;
            u32x4 o; o.x = pk4_fp8(bf2f((bf16)l0[0]), bf2f((bf16)l0[1]), bf2f((bf16)l0[2]), bf2f((bf16)l0[3])); o.y = pk4_fp8(bf2f((bf16)h0[0]), bf2f((bf16)h0[1]), bf2f((bf16)h0[2]), bf2f((bf16)h0[3]));
            o.z = pk4_fp8(bf2f((bf16)l1[0]), bf2f((bf16)l1[1]), bf2f((bf16)l1[2]), bf2f((bf16)l1[3])); o.w = pk4_fp8(bf2f((bf16)h1[0]), bf2f((bf16)h1[1]), bf2f((bf16)h1[2]), bf2f((bf16)h1[3]));
            *(u32x4*)(WT + n * K + kk) = o; }
    } else {
        const unsigned base = (unsigned)(size_t)scr + (unsigned)((8 * g + q) * 144 + pp * 8);
#pragma unroll
        for (int nb = 0; nb < 4; ++nb)
#pragma unroll
            for (int kh = 0; kh < 2; ++kh) {
                s16x4 lo, hi; const unsigned a0 = base + (unsigned)(32 * kh * 144 + 32 * nb);
                asm volatile("ds_read_b64_tr_b16 %0, %2\n\tds_read_b64_tr_b16 %1, %2 offset:576\n\ts_waitcnt lgkmcnt(0)" : "=&v"(lo), "=&v"(hi) : "v"(a0) : "memory");
                const size_t n = (size_t)(ndst0 + 16 * nb + j); const int kk = k0 + 32 * kh + 8 * g;
                bf16x8 o; o[0] = lo[0]; o[1] = lo[1]; o[2] = lo[2]; o[3] = lo[3]; o[4] = hi[0]; o[5] = hi[1]; o[6] = hi[2]; o[7] = hi[3];
                *(bf16x8*)(WT + (n * K + kk) * 2) = o; } }
    LDS_WAIT();
}
template <int PART> DI void prologue_phase(const Params& P, const Frame& F) {
    LAS unsigned char* scr = F.lds + F.wave * 9216;
    const int gw = (PART == 0 ? F.bid : F.bid - (GRID - NCONV)) * NWAVES + F.wave, NGW = (PART == 0 ? GRID : NCONV) * NWAVES;
    constexpr int I_WIN = 32 * 112, I_WOUT = 32 * 32, I_GU = 32 * 224, I_DN = 112 * 32, I_PG = 32 * 32, I_PP = 4 * 32;
    constexpr int C0 = 2 * I_WIN, C1 = C0 + 2 * I_WOUT, C2 = C1 + I_GU, C3 = C2 + I_DN, C4 = C3 + 8 * I_GU, C5 = C4 + 8 * I_DN, C6 = C5 + 2 * I_PG, C7 = C6 + 2 * I_PP;
    unsigned char* ws = P.ws;
    for (int it = (PART == 0 ? 0 : I_WIN) + gw; it < (PART == 0 ? I_WIN : C7); it += NGW) {
        const float* src; const float* src2 = nullptr; bf16* dst; int K, ldn, ntn, r, kind = 0; const bool f8 = (it >= C2 && it < C5) || (it >= C5 + I_PG && it < C6);
        if (it < C0)      { const int l = it / I_WIN; r = it % I_WIN; src = P.in[I_W_IN] + (size_t)l * D * NIN; dst = (bf16*)(ws + WS_WIN) + (size_t)l * NZ * D; K = D; ldn = NIN; ntn = NZ / 64; kind = 1; }
        else if (it < C1) { const int q = it - C0, l = q / I_WOUT; r = q % I_WOUT; src = P.in[I_W_OUT] + (size_t)l * D * D; dst = (bf16*)(ws + WS_WOUT) + (size_t)l * D * D; K = D; ldn = D; ntn = D / 64; }
        else if (it < C2) { r = it - C1; src = P.in[I_DG]; src2 = P.in[I_DU]; dst = (bf16*)(ws + WS_WGU); K = D; ldn = DFF; ntn = 2 * DFF / 64; kind = 2; }
        else if (it < C3) { r = it - C2; src = P.in[I_DD]; dst = (bf16*)(ws + WS_WD); K = DFF; ldn = D; ntn = D / 64; }
        else if (it < C4) { const int q = it - C3, e = q / I_GU; r = q % I_GU; src = P.in[I_MG] + (size_t)e * D * DFF; src2 = P.in[I_MU] + (size_t)e * D * DFF; dst = (bf16*)(ws + WS_MGU + (size_t)e * 2 * DFF * D); K = D; ldn = DFF; ntn = 2 * DFF / 64; kind = 2; }
        else if (it < C5) { const int q = it - C4, e = q / I_DN; r = q % I_DN; src = P.in[I_MD] + (size_t)e * DFF * D; dst = (bf16*)(ws + WS_MD + (size_t)e * D * DFF); K = DFF; ldn = D; ntn = D / 64; }
        else if (it < C6) { const int q = it - C5, l = q / I_PG; r = q % I_PG; src = P.in[I_PLE_GATE] + (size_t)l * D * D; dst = (bf16*)(ws + WS_WPG) + (size_t)l * D * D; K = D; ldn = D; ntn = D / 64; }
        else              { const int q = it - C6, l = q / I_PP; r = q % I_PP; src = P.in[I_PLE_PROJ] + (size_t)l * PLE * D; dst = (bf16*)(ws + WS_WPP) + (size_t)l * D * PLE; K = PLE; ldn = D; ntn = D / 64; }
        const int kb = r / ntn, nb = r % ntn, k0 = 64 * kb, ndst0 = 64 * nb;
        int nsrc0 = ndst0;
        if (kind == 1) nsrc0 = ndst0 + (ndst0 >= 3072 ? 8 : 0);
        if (kind == 2) { const int t = nb >> 2, q = nb & 3; if (q >= 2) src = src2; nsrc0 = 128 * t + 64 * (q & 1); }
        if (f8) tr_tile<true>(src, ldn, K, k0, nsrc0, (unsigned char*)dst, ndst0, scr, F.lane, (kind == 2 || it >= C5) ? (float)(1 << LS_WGU) : (float)(1 << LS_WD));
        else tr_tile<false>(src, ldn, K, k0, nsrc0, (unsigned char*)dst, ndst0, scr, F.lane, 1.0f);
    }
    if (PART == 1) return;
    const int gt = F.bid * NTHR + F.tid, NGT = F.G * NTHR;
    float* WGT = (float*)(ws + WS_WGT); float* WRT = (float*)(ws + WS_WRT);
    for (int e = gt; e < 2 * 16 * D; e += NGT) { const int l = e / (16 * D), j = (e / D) % 16, k = e % D; const int col = j < 8 ? 3072 + j : 7176 + (j - 8);
        WGT[e] = P.in[I_W_IN][((size_t)l * D + k) * NIN + col]; }
    for (int e = gt; e < NEXP * D; e += NGT) { const int j = e / D, k = e % D; WRT[e] = P.in[I_ROUTER][(size_t)k * NEXP + j]; }
}

template <int MODE, bool SB  > DI void norm_phase(const Params& P, const Frame& F, int L, const void* src_, const float* gain, bool combine) {
    const float* src = (const float*)src_; const bf16* srcb = (const bf16*)src_;
    unsigned char* ws = P.ws;
    const int r_lo = (int)((long)F.bid * M / F.G), r_hi = (int)((long)(F.bid + 1) * M / F.G);
    bf16* HN = (bf16*)(ws + WS_HN);
    if (MODE == 1) { const f32x4* w = (const f32x4*)((const float*)(ws + WS_WGT) + (size_t)L * 16 * D); for (int i = F.tid; i < 16 * D / 4; i += NTHR) ((LAS f32x4*)F.lds)[i] = w[i]; __syncthreads(); }
    if (MODE == 2) { const f32x4* w = (const f32x4*)(ws + WS_WRT); for (int i = F.tid; i < NEXP * D / 4; i += NTHR) ((LAS f32x4*)F.lds)[i] = w[i]; if (F.tid < 8) F.MISC[16 + F.tid] = 0u; __syncthreads(); }
    f32x4 g[8];
#pragma unroll
    for (int j = 0; j < 8; ++j) g[j] = *(const f32x4*)(gain + 4 * F.lane + 256 * j);
    f32x4 vn[SB ? 1 : 8]; u32x2 vb[SB ? 8 : 1];
#pragma unroll
    for (int j = 0; j < 8; ++j) { if constexpr (SB) vb[j] = *(const u32x2*)(srcb + (size_t)(r_lo + F.wave) * D + 4 * F.lane + 256 * j); else vn[j] = *(const f32x4*)(src + (size_t)(r_lo + F.wave) * D + 4 * F.lane + 256 * j); }
#pragma unroll 1
    for (int row = r_lo + F.wave; row < r_hi; row += NWAVES) {
        f32x4 v[8];
#pragma unroll
        for (int j = 0; j < 8; ++j) { if constexpr (SB) v[j] = (f32x4){bflo(vb[j].x), bfhi(vb[j].x), bflo(vb[j].y), bfhi(vb[j].y)}; else v[j] = vn[j]; }
        { const int rnx = (row + NWAVES < r_hi) ? row + NWAVES : row;
#pragma unroll
          for (int j = 0; j < 8; ++j) { if constexpr (SB) vb[j] = *(const u32x2*)(srcb + (size_t)rnx * D + 4 * F.lane + 256 * j); else vn[j] = *(const f32x4*)(src + (size_t)rnx * D + 4 * F.lane + 256 * j); } }
        if (MODE == 3 && combine) {
            const int* SLOT = (const int*)(ws + WS_SLOT); const float* TOPW = (const float*)(ws + WS_TOPW); const bf16* Y = (const bf16*)(ws + WS_T + T_YPERM);
            const int s1 = SLOT[row * 2], s2 = SLOT[row * 2 + 1]; const float w1 = TOPW[row * 2], w2 = TOPW[row * 2 + 1];
            u32x2 ya[8], yb[8];
#pragma unroll
            for (int j = 0; j < 8; ++j) { ya[j] = *(const u32x2*)(Y + (size_t)s1 * D + 4 * F.lane + 256 * j); yb[j] = *(const u32x2*)(Y + (size_t)s2 * D + 4 * F.lane + 256 * j); }
#pragma unroll
            for (int j = 0; j < 8; ++j) { const f32x4 y1 = (f32x4){bflo(ya[j].x), bfhi(ya[j].x), bflo(ya[j].y), bfhi(ya[j].y)}, y2 = (f32x4){bflo(yb[j].x), bfhi(yb[j].x), bflo(yb[j].y), bfhi(yb[j].y)};
                v[j] = v[j] + w1 * y1 + w2 * y2;
                const u32x2 hb = {pk2(v[j][0], v[j][1]), pk2(v[j][2], v[j][3])}; *(u32x2*)((bf16*)(ws + WS_H) + (size_t)row * D + 4 * F.lane + 256 * j) = hb;
                v[j] = (f32x4){bflo(hb.x), bfhi(hb.x), bflo(hb.y), bfhi(hb.y)}; }
        }
        float ss = 0.f;
#pragma unroll
        for (int j = 0; j < 8; ++j) ss += (v[j][0] * v[j][0] + v[j][1] * v[j][1]) + (v[j][2] * v[j][2] + v[j][3] * v[j][3]);
        const float rstd = 1.0f / sqrtf(wave_sum(ss) * (1.0f / D) + EPS);
#pragma unroll
        for (int j = 0; j < 8; ++j) v[j] = v[j] * rstd * g[j];
        if (MODE == 4) {
#pragma unroll
            for (int j = 0; j < 8; ++j) *(f32x4*)(P.out + (size_t)row * D + 4 * F.lane + 256 * j) = v[j];
        } else if (MODE == 2 || (MODE == 3 && L == 1)) {
            unsigned* o4 = (unsigned*)((unsigned char*)HN + (size_t)row * D) + F.lane; const float hs = (float)(1 << LS_HN);
#pragma unroll
            for (int j = 0; j < 8; ++j) o4[64 * j] = pk4_fp8(v[j][0] * hs, v[j][1] * hs, v[j][2] * hs, v[j][3] * hs);
        } else {
            unsigned long long* o8 = (unsigned long long*)(HN + (size_t)row * D) + F.lane;
#pragma unroll
            for (int j = 0; j < 8; ++j) o8[64 * j] = (unsigned long long)pk2(v[j][0], v[j][1]) | ((unsigned long long)pk2(v[j][2], v[j][3]) << 32);
        }
        if (MODE == 1) {
            float s[16];
#pragma unroll
            for (int q = 0; q < 16; ++q) { float t = 0.f;
#pragma unroll
                for (int j = 0; j < 8; ++j) { const f32x4 w = *(const LAS f32x4*)(F.lds + (size_t)(q * D + 256 * j + 4 * F.lane) * 4); t += (v[j][0] * w[0] + v[j][1] * w[1]) + (v[j][2] * w[2] + v[j][3] * w[3]); }
                s[q] = t; if ((q & 3) == 3) asm volatile("" ::: "memory"); }
#pragma unroll
            for (int i = 0; i < 8; ++i) { const bool hi = (F.lane & 32) != 0; const float send = hi ? s[i] : s[i + 8], keep = hi ? s[i + 8] : s[i]; s[i] = keep + shx<32>(send); }
#pragma unroll
            for (int i = 0; i < 4; ++i) { const bool hi = (F.lane & 16) != 0; const float send = hi ? s[i] : s[i + 4], keep = hi ? s[i + 4] : s[i]; s[i] = keep + shx<16>(send); }
#pragma unroll
            for (int i = 0; i < 2; ++i) { const bool hi = (F.lane & 8) != 0; const float send = hi ? s[i] : s[i + 2], keep = hi ? s[i + 2] : s[i]; s[i] = keep + shx<8>(send); }
            { const bool hi = (F.lane & 4) != 0; const float send = hi ? s[0] : s[1], keep = hi ? s[1] : s[0]; s[0] = keep + shx<4>(send); }
            float mine = s[0]; mine += shx<2>(mine); mine += shx<1>(mine);
            if ((F.lane & 3) == 0) { const int gi = ((F.lane >> 5) & 1) * 8 + ((F.lane >> 4) & 1) * 4 + ((F.lane >> 3) & 1) * 2 + ((F.lane >> 2) & 1), h = gi & 3; float r;
                if (gi < 4) r = sigmoidf_(mine);
                else if (gi < 8) r = -__expf(P.in[I_DN_A_LOG][L * 4 + h]) * softplusf_(mine + P.in[I_DN_DT_BIAS][L * 4 + h]);
                else if (gi < 12) r = mine + P.in[I_ML_I_BIAS][L * 4 + h];
                else r = -softplusf_(-(mine + P.in[I_ML_F_BIAS][L * 4 + h]));
                ((float*)(ws + WS_GD))[(size_t)row * 16 + gi] = r; }
        }
        if (MODE == 2) {
            int e1 = 0, e2 = 0; float l1 = -INFINITY, l2 = -INFINITY;
#pragma unroll 1
            for (int q = 0; q < 8; ++q) { float s = 0.f;
#pragma unroll
                for (int j = 0; j < 8; ++j) { const f32x4 w = *(const LAS f32x4*)(F.lds + (size_t)(q * D + 256 * j + 4 * F.lane) * 4); s += (v[j][0] * w[0] + v[j][1] * w[1]) + (v[j][2] * w[2] + v[j][3] * w[3]); }
                s = wave_sum(s);
                if (s > l1) { l2 = l1; e2 = e1; l1 = s; e1 = q; } else if (s > l2) { l2 = s; e2 = q; } }
            if (F.lane == 0) { const float w1 = 1.0f / (1.0f + __expf(l2 - l1));
                ((int*)(ws + WS_TOPE))[row * 2] = e1; ((int*)(ws + WS_TOPE))[row * 2 + 1] = e2; ((float*)(ws + WS_TOPW))[row * 2] = w1; ((float*)(ws + WS_TOPW))[row * 2 + 1] = 1.0f - w1;
                __hip_atomic_fetch_add((LAS unsigned*)&F.MISC[16 + e1], 1u, __ATOMIC_RELAXED, __HIP_MEMORY_SCOPE_WORKGROUP);
                __hip_atomic_fetch_add((LAS unsigned*)&F.MISC[16 + e2], 1u, __ATOMIC_RELAXED, __HIP_MEMORY_SCOPE_WORKGROUP); }
        }
        if (MODE == 3) { const f32x4 pv = *(const f32x4*)(P.in[I_P] + ((size_t)L * M + row) * PLE + 4 * F.lane);
            *((unsigned long long*)((bf16*)(ws + WS_T + T_PB) + (size_t)row * PLE) + F.lane) = (unsigned long long)pk2(pv[0], pv[1]) | ((unsigned long long)pk2(pv[2], pv[3]) << 32); }
    }
    if (MODE == 2) { __syncthreads(); if (F.tid < 8) ((int*)(ws + WS_BLKCNT))[F.bid * 8 + F.tid] = (int)F.MISC[16 + F.tid]; }
    if (MODE == 1 || MODE == 2) __syncthreads();
}

DI void moe_gather_phase(const Params& P, const Frame& F) {
    unsigned char* ws = P.ws;
    const int r_lo = (int)((long)F.bid * M / F.G), r_hi = (int)((long)(F.bid + 1) * M / F.G), nr = r_hi - r_lo;
    LAS int* tot = (LAS int*)F.lds; LAS int* pre = tot + 8; LAS int* base = tot + 16; LAS int* tope = tot + 64; LAS int* slots = tot + 64 + 1024;
    const int* BLK = (const int*)(ws + WS_BLKCNT); const int* TOPE = (const int*)(ws + WS_TOPE);
    if (F.tid < 16) tot[F.tid] = 0;
    __syncthreads();
    for (int i = F.tid; i < F.G * 8; i += NTHR) { const int v = BLK[i], c = i >> 3, e = i & 7;
        __hip_atomic_fetch_add(&tot[e], v, __ATOMIC_RELAXED, __HIP_MEMORY_SCOPE_WORKGROUP); if (c < F.bid) __hip_atomic_fetch_add(&pre[e], v, __ATOMIC_RELAXED, __HIP_MEMORY_SCOPE_WORKGROUP); }
    for (int i = F.tid; i < 2 * nr; i += NTHR) tope[i] = TOPE[r_lo * 2 + i];
    __syncthreads();
    if (F.tid == 0) {
        int off = 0; int* TILE_E = (int*)(ws + WS_TILEE);
        for (int e = 0; e < 8; ++e) { const int pad = (tot[e] + 255) & ~255; base[e] = off + pre[e];
            if (F.bid == 0) for (int t = off / 256; t < (off + pad) / 256; ++t) TILE_E[t] = e;
            off += pad; }
        if (F.bid == 0) TILE_E[255] = off / 256;
        int* SLOT = (int*)(ws + WS_SLOT);
        for (int i = 0; i < 2 * nr; ++i) { const int e = tope[i]; const int s = base[e]; base[e] = s + 1; slots[i] = s; SLOT[r_lo * 2 + i] = s; }
    }
    __syncthreads();
    const unsigned char* HN = (const unsigned char*)(ws + WS_HN); unsigned char* AP = (unsigned char*)(ws + WS_T + T_APERM);
    for (int i = F.tid >> 7; i < 2 * nr; i += 4) { const int row = r_lo + (i >> 1), s = slots[i];
        ((u32x4*)(AP + (size_t)s * D))[F.tid & 127] = ((const u32x4*)(HN + (size_t)row * D))[F.tid & 127]; }
    __syncthreads();
}

DI void prep_phase(const Params& P, const Frame& F, int L) {
    unsigned char* ws = P.ws;
    LAS float* CW = (LAS float*)F.lds;
    for (int i = F.tid; i < 4 * 2560; i += NTHR) { const int tap = i / 2560, ch = i % 2560;
        CW[i] = ch < 1536 ? P.in[I_CONV_DN][(size_t)(L * 4 + tap) * 1536 + ch] : P.in[I_CONV_ML][(size_t)(L * 4 + tap) * 1024 + ch - 1536]; }
    __syncthreads();
    const int gw = F.bid * NWAVES + F.wave, NGW = F.G * NWAVES;
    const float* GD = (const float*)(ws + WS_GD);
    if (gw < 32) {
        const int b = gw >> 2, h = gw & 3; float m_st = 0.f; float* MLS = (float*)(ws + WS_MLS); float* MLCS = (float*)(ws + WS_MLCS);
        float lfa[32], ipa[32];
#pragma unroll
        for (int n = 0; n < 32; ++n) { const size_t row = (size_t)b * SEQ + 64 * n + F.lane; lfa[n] = GD[row * 16 + 12 + h]; ipa[n] = GD[row * 16 + 8 + h]; }
        float pma[32], bla[32], pxa[32];
#pragma unroll
        for (int n = 0; n < 32; ++n) { const float bc = wave_incl_sum(lfa[n], F.lane); bla[n] = __shfl(bc, 63); const float e = ipa[n] - bc; const float pm = wave_incl_max(e, F.lane); pxa[n] = __shfl(pm, 63);
            lfa[n] = bc; ipa[n] = e; pma[n] = pm; }
#pragma unroll
        for (int n = 0; n < 32; ++n) {
            const size_t row = (size_t)b * SEQ + 64 * n + F.lane;
            const float bc = lfa[n], e = ipa[n], blast = bla[n], pmax = pxa[n];
            const float mt = fmaxf(bc + pma[n], bc + m_st), m_new = fmaxf(blast + m_st, blast + pmax);
            *(f32x4*)(MLS + (row * 4 + h) * 8) = (f32x4){e, bc - mt, __expf(bc + m_st - mt), __expf(-mt)};
            if (F.lane == 0) { MLCS[(b * 4 + h) * 32 + n] = __expf(blast + m_st - m_new); MLCS[NCHUNK + (b * 4 + h) * 32 + n] = __expf(blast + pmax - m_new); }
            m_st = m_new;
        }
    }
    const bf16* Z = (const bf16*)(ws + WS_T + T_Z); bf16* ZC = (bf16*)(ws + WS_T + T_ZC);
    {
        static_assert(M / (GRID * NWAVES) == 8, "prep: 8 rows per wave");
        const int rbeg = gw * 8; const bool hist = (rbeg % SEQ) != 0;
        const __amdgpu_buffer_rsrc_t rz = __builtin_amdgcn_make_buffer_rsrc((void*)Z, 0, 0xFFFFFFFF, 0x00020000), rc = __builtin_amdgcn_make_buffer_rsrc((void*)ZC, 0, 0xFFFFFFFF, 0x00020000);
#pragma unroll 1
        for (int i = 0; i < 5; ++i) {
            const int vo = F.lane * 16 + 1024 * i;
            u32x4 rows[11];
#pragma unroll
            for (int k = 0; k < 11; ++k) rows[k] = (k >= 3 || hist) ? *(const u32x4*)((const unsigned char*)Z + (size_t)(rbeg - 3 + k) * (NZ * 2) + vo) : (u32x4){0u, 0u, 0u, 0u};
            f32x4 w[4][2];
#pragma unroll
            for (int tap = 0; tap < 4; ++tap) { const LAS unsigned char* wp = (const LAS unsigned char*)CW + F.lane * 32 + (tap * 2560 + 512 * i) * 4; w[tap][0] = *(const LAS f32x4*)wp; w[tap][1] = *(const LAS f32x4*)(wp + 16); }
            const float qs = (i == 0 || i == 4) ? 0.08838834764831845f : 1.0f; const bool nrm = i < 2;
#pragma unroll
            for (int r = 0; r < 8; ++r) {
                float a[8];
#pragma unroll
                for (int e = 0; e < 8; ++e) a[e] = 0.f;
#pragma unroll
                for (int tap = 0; tap < 4; ++tap) { const u32x4 x = rows[r + tap];
                    a[0] += bflo(x.x) * w[tap][0][0]; a[1] += bfhi(x.x) * w[tap][0][1]; a[2] += bflo(x.y) * w[tap][0][2]; a[3] += bfhi(x.y) * w[tap][0][3];
                    a[4] += bflo(x.z) * w[tap][1][0]; a[5] += bfhi(x.z) * w[tap][1][1]; a[6] += bflo(x.w) * w[tap][1][2]; a[7] += bfhi(x.w) * w[tap][1][3]; }
                float ss = 0.f;
#pragma unroll
                for (int e = 0; e < 8; ++e) { a[e] = siluf_(a[e]); ss += a[e] * a[e]; }
                ss += shx<1>(ss); ss += shx<2>(ss); ss += shx<4>(ss); ss += shx<8>(ss);
                const float sc = (nrm ? __builtin_amdgcn_rsqf(ss + EPS) : 1.0f) * qs;
                u32x4 o; o.x = pk2(a[0] * sc, a[1] * sc); o.y = pk2(a[2] * sc, a[3] * sc); o.z = pk2(a[4] * sc, a[5] * sc); o.w = pk2(a[6] * sc, a[7] * sc);
                *(u32x4*)((unsigned char*)ZC + (size_t)(rbeg + r) * (2560 * 2) + vo) = o;
            }
        }
    }
    __syncthreads();
}

constexpr int ATT_STAGE = 35840, ATT_KMAP = 9216, ATT_VOFF = 18432, ATT_KRS = 144, ATT_VRS = 272;
DI void attn_block(const Params& P, const Frame& F, int L, int b, int h, int qb, float lam, float oml) {
    unsigned char* ws = P.ws;
    const bf16* Z = (const bf16*)(ws + WS_T + T_Z); bf16* MIX = (bf16*)(ws + WS_T + T_MIX);
    const int lane = F.lane, c = lane & 15, rq = lane >> 4, wave = F.wave;
    const int q0 = qb * 128, qrow = q0 + 16 * wave + c;
    const size_t rowbase = (size_t)b * SEQ;
    bf16x8 qf[2][2];
#pragma unroll
    for (int j = 0; j < 2; ++j)
#pragma unroll
        for (int ks = 0; ks < 2; ++ks) qf[j][ks] = *(const bf16x8*)(Z + (rowbase + qrow) * NZ + 3072 + h * 128 + j * 64 + 32 * ks + 8 * rq);
    const float LOG2E = 1.4426950408889634f;
    const float sc = 0.125f * LOG2E, sl = __builtin_bit_cast(float, __builtin_amdgcn_readfirstlane(__builtin_bit_cast(int, exp2f(-(float)(h + 1)) * LOG2E)));
#pragma unroll
    for (int j = 0; j < 2; ++j)
#pragma unroll
        for (int ks = 0; ks < 2; ++ks) { const u32x4 qv = __builtin_bit_cast(u32x4, qf[j][ks]); u32x4 o;
            o.x = pk2(bflo(qv.x) * sc, bfhi(qv.x) * sc); o.y = pk2(bflo(qv.y) * sc, bfhi(qv.y) * sc); o.z = pk2(bflo(qv.z) * sc, bfhi(qv.z) * sc); o.w = pk2(bflo(qv.w) * sc, bfhi(qv.w) * sc);
            qf[j][ks] = __builtin_bit_cast(bf16x8, o); }
    float sbias[16];
#pragma unroll
    for (int i = 0; i < 16; ++i) sbias[i] = __builtin_bit_cast(float, __builtin_amdgcn_readfirstlane(__builtin_bit_cast(int, sl * (float)(16 * (i >> 2) + (i & 3)))));
    f32x4 O[2][8];
#pragma unroll
    for (int j = 0; j < 2; ++j)
#pragma unroll
        for (int d = 0; d < 8; ++d) O[j][d] = (f32x4){0.f, 0.f, 0.f, 0.f};
    float mrun[2] = {-INFINITY, -INFINITY}, lrun[2] = {0.f, 0.f};
    const int nkt = 2 * (qb + 1);
    u32x4 st[4];
#define ATT_LOAD(kt_) do { const int k0_ = 64 * (kt_); _Pragma("unroll") for (int i_ = 0; i_ < 2; ++i_) { const int id_ = F.tid + 512 * i_, key_ = id_ >> 4, ch_ = id_ & 15; \
        st[i_] = *(const u32x4*)(Z + (rowbase + k0_ + key_) * NZ + 4096 + h * 128 + ch_ * 8); st[2 + i_] = *(const u32x4*)(Z + (rowbase + k0_ + key_) * NZ + 5120 + h * 128 + ch_ * 8); } } while (0)
#define ATT_STORE(s_) do { LAS unsigned char* sb_ = F.lds + (s_) * ATT_STAGE; _Pragma("unroll") for (int i_ = 0; i_ < 2; ++i_) { const int id_ = F.tid + 512 * i_, key_ = id_ >> 4, ch_ = id_ & 15; \
        *(LAS u32x4*)(sb_ + (ch_ >> 3) * ATT_KMAP + key_ * ATT_KRS + (ch_ & 7) * 16) = st[i_]; *(LAS u32x4*)(sb_ + ATT_VOFF + key_ * ATT_VRS + ch_ * 16) = st[2 + i_]; } } while (0)
    ATT_LOAD(nkt - 1); ATT_STORE(0); __syncthreads();
#pragma unroll 1
    for (int kk = 0; kk < nkt; ++kk) {
        const int kt = nkt - 1 - kk;
        if (kk + 1 < nkt) ATT_LOAD(kt - 1);
        const int k0 = 64 * kt;
        if (k0 <= q0 + 16 * wave + 15) {
            const LAS unsigned char* Kb = F.lds + (kk & 1) * ATT_STAGE;
            const unsigned Va = (unsigned)(size_t)(F.lds + (kk & 1) * ATT_STAGE + ATT_VOFF);
            const bool diag = (k0 + 63 > q0 + 16 * wave);
            const int lim = qrow - k0 - 4 * rq;
            const float base2 = sl * (float)(k0 + 4 * rq - qrow);
            bf16x8 pf[2][2];
#pragma unroll
            for (int j = 0; j < 2; ++j) {
                f32x2 x2[8]; float mx = -INFINITY;
#pragma unroll
                for (int nt = 0; nt < 4; ++nt) {
                    f32x4 a = (f32x4){0.f, 0.f, 0.f, 0.f};
#pragma unroll
                    for (int ks = 0; ks < 2; ++ks) a = MFMA16(frag_row(Kb + j * ATT_KMAP, ATT_KRS, 16 * nt, 32 * ks, lane), qf[j][ks], a);
                    x2[2 * nt] = (f32x2){a[0], a[1]} + (f32x2){sbias[4 * nt], sbias[4 * nt + 1]}; x2[2 * nt + 1] = (f32x2){a[2], a[3]} + (f32x2){sbias[4 * nt + 2], sbias[4 * nt + 3]};
                }
                if (diag) {
#pragma unroll
                    for (int i = 0; i < 8; ++i) { x2[i].x = (16 * (i >> 1) + 2 * (i & 1) <= lim) ? x2[i].x : -INFINITY; x2[i].y = (16 * (i >> 1) + 2 * (i & 1) + 1 <= lim) ? x2[i].y : -INFINITY; } }
#pragma unroll
                for (int i = 0; i < 8; ++i) { mx = fmaxf(mx, x2[i].x); mx = fmaxf(mx, x2[i].y); }
                mx += base2;
                mx = fmaxf(mx, shx<16>(mx)); mx = fmaxf(mx, shx<32>(mx));
                const float mnew = fmaxf(mrun[j], mx), alpha = __builtin_amdgcn_exp2f(mrun[j] - mnew), msub = mnew - base2;
                const f32x2 ms2 = (f32x2){msub, msub}; f32x2 ps2 = (f32x2){0.f, 0.f};
#pragma unroll
                for (int i = 0; i < 8; ++i) { const f32x2 t = x2[i] - ms2; x2[i] = (f32x2){__builtin_amdgcn_exp2f(t.x), __builtin_amdgcn_exp2f(t.y)}; ps2 = ps2 + x2[i]; }
                lrun[j] = lrun[j] * alpha + (ps2.x + ps2.y); mrun[j] = mnew;
                if (__builtin_amdgcn_ballot_w64(alpha != 1.0f) != 0ull) {
#pragma unroll
                    for (int d = 0; d < 8; ++d) O[j][d] = O[j][d] * alpha; }
#pragma unroll
                for (int k2 = 0; k2 < 2; ++k2) { u32x4 w; w.x = pk2(x2[4 * k2].x, x2[4 * k2].y); w.y = pk2(x2[4 * k2 + 1].x, x2[4 * k2 + 1].y); w.z = pk2(x2[4 * k2 + 2].x, x2[4 * k2 + 2].y); w.w = pk2(x2[4 * k2 + 3].x, x2[4 * k2 + 3].y);
                    pf[j][k2] = __builtin_bit_cast(bf16x8, w); }
            }
            {
                const int tq = (lane & 15) >> 2, tp = lane & 3;
                const unsigned ab = Va + (unsigned)((4 * rq + tq) * ATT_VRS + 8 * tp);
                s16x4 va[8], vb[8], vc[8], vd[8];
#define ATT_TR8(dst, addr) asm volatile("ds_read_b64_tr_b16 %0, %8\n\tds_read_b64_tr_b16 %1, %8 offset:32\n\tds_read_b64_tr_b16 %2, %8 offset:64\n\tds_read_b64_tr_b16 %3, %8 offset:96\n\t" \
                    "ds_read_b64_tr_b16 %4, %8 offset:128\n\tds_read_b64_tr_b16 %5, %8 offset:160\n\tds_read_b64_tr_b16 %6, %8 offset:192\n\tds_read_b64_tr_b16 %7, %8 offset:224" \
                    : "=&v"(dst[0]), "=&v"(dst[1]), "=&v"(dst[2]), "=&v"(dst[3]), "=&v"(dst[4]), "=&v"(dst[5]), "=&v"(dst[6]), "=&v"(dst[7]) : "v"(addr) : "memory")
                ATT_TR8(va, ab); ATT_TR8(vb, ab + 16 * ATT_VRS);
                asm volatile("s_waitcnt lgkmcnt(0)" : "+v"(va[0]), "+v"(va[1]), "+v"(va[2]), "+v"(va[3]), "+v"(va[4]), "+v"(va[5]), "+v"(va[6]), "+v"(va[7]), "+v"(vb[0]), "+v"(vb[1]), "+v"(vb[2]), "+v"(vb[3]), "+v"(vb[4]), "+v"(vb[5]), "+v"(vb[6]), "+v"(vb[7]) :: "memory");
#pragma unroll
                for (int d = 0; d < 8; ++d) { bf16x8 vf; vf[0] = va[d][0]; vf[1] = va[d][1]; vf[2] = va[d][2]; vf[3] = va[d][3]; vf[4] = vb[d][0]; vf[5] = vb[d][1]; vf[6] = vb[d][2]; vf[7] = vb[d][3];
                    O[0][d] = MFMA16(vf, pf[0][0], O[0][d]); O[1][d] = MFMA16(vf, pf[1][0], O[1][d]); }
                ATT_TR8(vc, ab + 32 * ATT_VRS); ATT_TR8(vd, ab + 48 * ATT_VRS);
                asm volatile("s_waitcnt lgkmcnt(0)" : "+v"(vc[0]), "+v"(vc[1]), "+v"(vc[2]), "+v"(vc[3]), "+v"(vc[4]), "+v"(vc[5]), "+v"(vc[6]), "+v"(vc[7]), "+v"(vd[0]), "+v"(vd[1]), "+v"(vd[2]), "+v"(vd[3]), "+v"(vd[4]), "+v"(vd[5]), "+v"(vd[6]), "+v"(vd[7]) :: "memory");
#pragma unroll
                for (int d = 0; d < 8; ++d) { bf16x8 vf; vf[0] = vc[d][0]; vf[1] = vc[d][1]; vf[2] = vc[d][2]; vf[3] = vc[d][3]; vf[4] = vd[d][0]; vf[5] = vd[d][1]; vf[6] = vd[d][2]; vf[7] = vd[d][3];
                    O[0][d] = MFMA16(vf, pf[0][1], O[0][d]); O[1][d] = MFMA16(vf, pf[1][1], O[1][d]); }
#undef ATT_TR8
            }
        }
        if (kk + 1 < nkt) ATT_STORE((kk + 1) & 1);
        __syncthreads();
    }
#undef ATT_LOAD
#undef ATT_STORE
    const float* nw = P.in[I_DIFF_NORM] + L * 128;
    f32x4 nwv[8];
#pragma unroll
    for (int d = 0; d < 8; ++d) nwv[d] = *(const f32x4*)(nw + 16 * d + 4 * rq);
    float inv[2];
#pragma unroll
    for (int j = 0; j < 2; ++j) { float l = lrun[j]; l += shx<16>(l); l += shx<32>(l); inv[j] = __builtin_amdgcn_rcpf(l); }
    const float inv1l = lam * inv[1];
    float ss = 0.f;
#pragma unroll
    for (int d = 0; d < 8; ++d)
#pragma unroll
        for (int e = 0; e < 4; ++e) { const float o = O[0][d][e] * inv[0] - O[1][d][e] * inv1l; O[0][d][e] = o; ss += o * o; }
    ss += shx<16>(ss); ss += shx<32>(ss);
    const float r = oml * __builtin_amdgcn_rsqf(ss * (1.0f / 128.0f) + EPS);
    unsigned long long ov[8];
#pragma unroll
    for (int d = 0; d < 8; ++d) ov[d] = (unsigned long long)pk2(O[0][d][0] * r * nwv[d][0], O[0][d][1] * r * nwv[d][1]) | ((unsigned long long)pk2(O[0][d][2] * r * nwv[d][2], O[0][d][3] * r * nwv[d][3]) << 32);
#pragma unroll
    for (int d = 0; d < 8; ++d) *(unsigned long long*)(MIX + (rowbase + qrow) * D + 512 + h * 128 + 16 * d + 4 * rq) = ov[d];
}

template <int NW> DI void dn1_unit(const Params& P, const Frame& F, int cidx) {
    constexpr int NT = NW * 64;
    unsigned char* ws = P.ws;
    const int bh = cidx >> 5, n = cidx & 31, b = bh >> 2, h = bh & 3; const size_t r0 = (size_t)b * SEQ + 64 * n;
    const bf16* ZC = (const bf16*)(ws + WS_T + T_ZC); const float* GD = (const float*)(ws + WS_GD);
    LAS unsigned char* Qs = F.lds + 16896; LAS unsigned char* Ks = F.lds + 34304; LAS unsigned char* Vs = F.lds + 51712;
    LAS float* Am = (LAS float*)(F.lds); LAS float* gcs = (LAS float*)(F.lds + 16384); LAS float* bts = (LAS float*)(F.lds + 16640);
    const int lane = F.lane, c = lane & 15, rq = lane >> 4;
    for (int id = F.tid; id < 3072; id += NT) { const int which = id >> 10, rem = id & 1023, row = rem >> 4, ch = rem & 15;
        *(LAS u32x4*)(Qs + which * 17408 + row * 272 + ch * 16) = *(const u32x4*)(ZC + (r0 + row) * 2560 + which * 512 + h * 128 + ch * 8); }
    if (F.tid < 64) { bts[F.tid] = GD[(r0 + F.tid) * 16 + h]; const float gc = wave_incl_sum(GD[(r0 + F.tid) * 16 + 4 + h], lane); gcs[F.tid] = gc;
        if (lane == 63) ((float*)(ws + WS_DNGL))[cidx] = __expf(gc); }
    __syncthreads();
    bf16* ATT = (bf16*)(ws + WS_T + T_ATT) + (size_t)cidx * 4096;
    for (int ti = 0; ti < 32 / NW; ++ti) {
        const int idx = F.wave * (32 / NW) + ti, isqk = idx >> 4, mt = (idx & 15) >> 2, nt = idx & 3;
        if (!isqk && mt < nt) continue;
        f32x4 a = (f32x4){0.f, 0.f, 0.f, 0.f};
        if (mt >= nt) {
#pragma unroll
            for (int ks = 0; ks < 4; ++ks) a = MFMA16(frag_row(isqk ? Qs : Ks, 272, 16 * mt, 32 * ks, lane), frag_row(Ks, 272, 16 * nt, 32 * ks, lane), a);
        }
        const int j = 16 * nt + c; const float gj = gcs[j];
#pragma unroll
        for (int e = 0; e < 4; ++e) { const int i = 16 * mt + 4 * rq + e; const float dec = __expf(gcs[i] - gj);
            if (!isqk) Am[i * 64 + j] = (i > j) ? bts[i] * a[e] * dec : 0.f;
            else ATT[i * 64 + j] = (bf16)f2bf((i >= j) ? a[e] * dec : 0.f); }
    }
    __syncthreads();
    if (NW == 4 || F.wave < 4) {
        const int cc = F.tid, d = cc & 127; const bool isw = cc >= 128;
        const LAS unsigned char* srcT = (isw ? Ks : Vs) + d * 2;
        float* up = (float*)(ws + WS_T + T_U) + r0 * 512 + h * 128 + d; bf16* wp = (bf16*)(ws + WS_T + T_W) + r0 * 512 + h * 128 + d;
        float x[64];
#pragma unroll
        for (int i = 0; i < 64; ++i) {
            const float gm = isw ? __expf(gcs[i]) : 1.0f;
            float acc = bf2f(*(const LAS bf16*)(srcT + i * 272)) * bts[i] * gm;
            float pa[4] = {0.f, 0.f, 0.f, 0.f};
#pragma unroll
            for (int j4 = 0; j4 < (i + 3) / 4; ++j4) { const f32x4 av = *(const LAS f32x4*)(Am + i * 64 + 4 * j4);
#pragma unroll
                for (int e = 0; e < 4; ++e) if (4 * j4 + e < i) pa[e] += av[e] * x[4 * j4 + e]; }
            acc -= (pa[0] + pa[1]) + (pa[2] + pa[3]);
            x[i] = acc;
            if (isw) *wp = (bf16)f2bf(acc); else *up = acc;
            up += 512; wp += 512; asm volatile("" : "+v"(up), "+v"(wp));
        }
    }
    if (NW == 4 || F.wave >= 4) {
        const int t = (NW == 4) ? F.tid : F.tid - 256;
        bf16* QG = (bf16*)(ws + WS_T + T_QG); bf16* KGT = (bf16*)(ws + WS_T + T_KGT) + (size_t)cidx * 8192;
        for (int idx = t; idx < 1024; idx += 256) { const int row = idx >> 4, ch = idx & 15; const u32x4 q = *(const LAS u32x4*)(Qs + row * 272 + ch * 16); const float eg = __expf(gcs[row]);
            u32x4 o; o.x = pk2(bflo(q.x) * eg, bfhi(q.x) * eg); o.y = pk2(bflo(q.y) * eg, bfhi(q.y) * eg); o.z = pk2(bflo(q.z) * eg, bfhi(q.z) * eg); o.w = pk2(bflo(q.w) * eg, bfhi(q.w) * eg);
            *(u32x4*)(QG + (r0 + row) * 512 + h * 128 + ch * 8) = o; }
        const float glast = gcs[63];
        for (int idx = t; idx < 1024; idx += 256) { const int dd = idx >> 3, ic = idx & 7; float v[8];
#pragma unroll
            for (int e = 0; e < 8; ++e) { const int i = 8 * ic + e; v[e] = bf2f(*(const LAS bf16*)(Ks + i * 272 + dd * 2)) * __expf(glast - gcs[i]); }
            u32x4 o; o.x = pk2(v[0], v[1]); o.y = pk2(v[2], v[3]); o.z = pk2(v[4], v[5]); o.w = pk2(v[6], v[7]);
            *(u32x4*)(KGT + dd * 64 + 8 * ic) = o; }
    }
    __syncthreads();
}

template <int NW> DI void ml1_unit(const Params& P, const Frame& F, int cidx) {
    constexpr int NT = NW * 64;
    unsigned char* ws = P.ws;
    const int bh = cidx >> 5, n = cidx & 31, b = bh >> 2, h = bh & 3; const size_t r0 = (size_t)b * SEQ + 64 * n;
    const bf16* Z = (const bf16*)(ws + WS_T + T_Z); const bf16* ZC = (const bf16*)(ws + WS_T + T_ZC); const float* MLS = (const float*)(ws + WS_MLS);
    LAS unsigned char* Vs = F.lds; LAS unsigned char* KWs = F.lds + 17408;
    const int lane = F.lane, c = lane & 15, rq = lane >> 4;
    LAS float* wl = (LAS float*)(F.lds + 34816);
    { const float* GD = (const float*)(ws + WS_GD);
      if (F.tid < 64) { const float lf = GD[(r0 + F.tid) * 16 + 12 + h], ip = GD[(r0 + F.tid) * 16 + 8 + h]; const float e = ip - wave_incl_sum(lf, lane); wl[F.tid] = __expf(e - wave_max(e)); } }
    __syncthreads();
    for (int id = F.tid; id < 2048; id += NT) { const int which = id >> 10, rem = id & 1023, row = rem >> 4, ch = rem & 15;
        if (which == 0) *(LAS u32x4*)(Vs + row * 272 + ch * 16) = *(const u32x4*)(Z + (r0 + row) * NZ + 6144 + h * 128 + ch * 8);
        else { const u32x4 k = *(const u32x4*)(ZC + (r0 + row) * 2560 + 2048 + h * 128 + ch * 8); const float w = wl[row];
            u32x4 o; o.x = pk2(bflo(k.x) * w, bfhi(k.x) * w); o.y = pk2(bflo(k.y) * w, bfhi(k.y) * w); o.z = pk2(bflo(k.z) * w, bfhi(k.z) * w); o.w = pk2(bflo(k.w) * w, bfhi(k.w) * w);
            *(LAS u32x4*)(KWs + row * 272 + ch * 16) = o; } }
    __syncthreads();
    float* DCT = (float*)(ws + WS_T + T_DCT) + (size_t)cidx * 16512;
    const unsigned Va = (unsigned)(size_t)Vs, Ka = (unsigned)(size_t)KWs;
#pragma unroll
    for (int mi = 0; mi < 8 / NW; ++mi) { const int mt = F.wave + NW * mi;
        bf16x8 af[2];
#pragma unroll
        for (int ks = 0; ks < 2; ++ks) af[ks] = frag_tr(Va, 272, 32 * ks, 16 * mt, lane);
#pragma unroll
        for (int nt = 0; nt < 8; ++nt) { f32x4 a = (f32x4){0.f, 0.f, 0.f, 0.f};
#pragma unroll
            for (int ks = 0; ks < 2; ++ks) a = MFMA16(af[ks], frag_tr(Ka, 272, 32 * ks, 16 * nt, lane), a);
#pragma unroll
            for (int e = 0; e < 4; ++e) DCT[(16 * mt + 4 * rq + e) * 128 + 16 * nt + c] = a[e]; } }
    if (F.tid < 128) { float s = 0.f; for (int j = 0; j < 64; ++j) s += bf2f(*(const LAS bf16*)(KWs + j * 272 + F.tid * 2)); DCT[128 * 128 + F.tid] = s; }
    __syncthreads();
}

DI void ml2_scan(const Params& P, int gt, int NGT) {
    unsigned char* ws = P.ws;
    const float* DCT = (const float*)(ws + WS_T + T_DCT); bf16* CST = (bf16*)(ws + WS_T + T_CST); const float* MLCS = (const float*)(ws + WS_MLCS);
    for (int g = gt; g < 32 * 4128; g += NGT) { const int bh = g / 4128, idx = (g % 4128) * 4; f32x4 cst = (f32x4){0.f, 0.f, 0.f, 0.f};
#pragma unroll 1
        for (int n0 = 0; n0 < 32; n0 += 8) { f32x4 d[8]; float cs[8];
#pragma unroll
            for (int k = 0; k < 8; ++k) { const int cid = bh * 32 + n0 + k; d[k] = *(const f32x4*)(DCT + (size_t)cid * 16512 + idx) * MLCS[NCHUNK + cid]; cs[k] = MLCS[cid]; }
#pragma unroll
            for (int k = 0; k < 8; ++k) { const int cid = bh * 32 + n0 + k;
                *(unsigned long long*)(CST + (size_t)cid * 18432 + idx) = (unsigned long long)pk2(cst[0], cst[1]) | ((unsigned long long)pk2(cst[2], cst[3]) << 32);
                cst = cs[k] * cst + d[k]; } } }
}

DI void head_gate_load(const Frame& F, const bf16* gsrc  , u32x4& g0, u32x4& g1) {
    const int row = F.tid >> 3, seg = F.tid & 7;
    g0 = *(const u32x4*)(gsrc + (size_t)row * NZ + 16 * seg); g1 = *(const u32x4*)(gsrc + (size_t)row * NZ + 16 * seg + 8);
}
DI void head_nw_load(const Frame& F, const float* nw, f32x4 (&nwv)[4]) { const int seg = F.tid & 7;
#pragma unroll
    for (int q = 0; q < 4; ++q) nwv[q] = *(const f32x4*)(nw + 16 * seg + 4 * q); }
template <int GATE> DI void head_norm_store(const Frame& F, const LAS float* Hs, const f32x4 (&nwv)[4], const u32x4 g0, const u32x4 g1, bf16* dst  ) {
    const int row = F.tid >> 3, seg = F.tid & 7;
    float v[16]; float ss = 0.f;
#pragma unroll
    for (int e = 0; e < 16; ++e) { v[e] = Hs[row * 132 + 16 * seg + e]; ss += v[e] * v[e]; }
    ss += shx<1>(ss); ss += shx<2>(ss); ss += shx<4>(ss);
    const float r = 1.0f / sqrtf(ss * (1.0f / 128.0f) + EPS);
    float gt[16] = {bflo(g0.x), bfhi(g0.x), bflo(g0.y), bfhi(g0.y), bflo(g0.z), bfhi(g0.z), bflo(g0.w), bfhi(g0.w), bflo(g1.x), bfhi(g1.x), bflo(g1.y), bfhi(g1.y), bflo(g1.z), bfhi(g1.z), bflo(g1.w), bfhi(g1.w)};
#pragma unroll
    for (int e = 0; e < 16; ++e) v[e] = v[e] * r * nwv[e >> 2][e & 3] * (GATE == 0 ? siluf_(gt[e]) : sigmoidf_(gt[e]));
    u32x4 o0, o1; o0.x = pk2(v[0], v[1]); o0.y = pk2(v[2], v[3]); o0.z = pk2(v[4], v[5]); o0.w = pk2(v[6], v[7]); o1.x = pk2(v[8], v[9]); o1.y = pk2(v[10], v[11]); o1.z = pk2(v[12], v[13]); o1.w = pk2(v[14], v[15]);
    *(u32x4*)(dst + (size_t)row * D + 16 * seg) = o0; *(u32x4*)(dst + (size_t)row * D + 16 * seg + 8) = o1;
}

struct Dn2A { bf16x8 wf[4]; };
struct Dn2B { bf16x8 qf[4], af[2], kf[2]; float gl; };
DI void dn2_load_a(const Params& P, const Frame& F, int bh, int n, Dn2A& o) {
    unsigned char* ws = P.ws;
    const int b = bh >> 2, h = bh & 3, lane = F.lane, c = lane & 15, rq = lane >> 4, w = F.wave, mt = w >> 1;
    const size_t r0 = (size_t)b * SEQ + 64 * n;
    const bf16* W = (const bf16*)(ws + WS_T + T_W);
#pragma unroll
    for (int ks = 0; ks < 4; ++ks) o.wf[ks] = *(const bf16x8*)(W + (r0 + 16 * mt + c) * 512 + h * 128 + 32 * ks + 8 * rq);
}
DI void dn2_load_u(const Params& P, const Frame& F, int bh, int n, float (&u)[4][4]) {
    unsigned char* ws = P.ws;
    const int b = bh >> 2, h = bh & 3, lane = F.lane, c = lane & 15, rq = lane >> 4, w = F.wave, mt = w >> 1, ntb = (w & 1) * 4;
    const size_t r0 = (size_t)b * SEQ + 64 * n; const float* U = (const float*)(ws + WS_T + T_U);
#pragma unroll
    for (int t = 0; t < 4; ++t)
#pragma unroll
        for (int e = 0; e < 4; ++e) u[t][e] = U[(r0 + 16 * mt + 4 * rq + e) * 512 + h * 128 + 16 * (ntb + t) + c];
}
DI void dn2_load_b(const Params& P, const Frame& F, int bh, int n, Dn2B& o) {
    unsigned char* ws = P.ws;
    const int b = bh >> 2, h = bh & 3, lane = F.lane, c = lane & 15, rq = lane >> 4, w = F.wave, mt = w >> 1;
    const int cid = bh * 32 + n; const size_t r0 = (size_t)b * SEQ + 64 * n;
    const bf16* QG = (const bf16*)(ws + WS_T + T_QG);
    const bf16* ATT = (const bf16*)(ws + WS_T + T_ATT) + (size_t)cid * 4096; const bf16* KGT = (const bf16*)(ws + WS_T + T_KGT) + (size_t)cid * 8192;
    o.gl = ((const float*)(ws + WS_DNGL))[cid];
#pragma unroll
    for (int ks = 0; ks < 4; ++ks) o.qf[ks] = *(const bf16x8*)(QG + (r0 + 16 * mt + c) * 512 + h * 128 + 32 * ks + 8 * rq);
#pragma unroll
    for (int ks = 0; ks < 2; ++ks) { o.af[ks] = *(const bf16x8*)(ATT + (16 * mt + c) * 64 + 32 * ks + 8 * rq); o.kf[ks] = *(const bf16x8*)(KGT + (16 * w + c) * 64 + 32 * ks + 8 * rq); }
}
DI void dn2_block(const Params& P, const Frame& F, int L, int bh) {
    unsigned char* ws = P.ws;
    const int b = bh >> 2, h = bh & 3, lane = F.lane, c = lane & 15, rq = lane >> 4, w = F.wave;
    LAS unsigned char* St0 = F.lds; LAS unsigned char* VnT = F.lds + 69632; LAS float* Os = (LAS float*)(F.lds + 88064);
    bf16* MIX = (bf16*)(ws + WS_T + T_MIX);
    for (int i = F.tid; i < 34816 / 16; i += NTHR) ((LAS u32x4*)St0)[i] = (u32x4){0u, 0u, 0u, 0u};
    f32x4 sreg[8];
#pragma unroll
    for (int nt = 0; nt < 8; ++nt) sreg[nt] = (f32x4){0.f, 0.f, 0.f, 0.f};
    LAS float* nws = (LAS float*)(F.lds + 121856); if (F.tid < 128) nws[F.tid] = P.in[I_DN_NORM][L * 128 + F.tid];
    Dn2A cur, nxt; Dn2B ob; u32x4 gp0 = (u32x4){0u, 0u, 0u, 0u}, gp1 = gp0;
    dn2_load_a(P, F, bh, 0, cur);
    __syncthreads();
    const int mt = w >> 1, ntb = (w & 1) * 4;
#pragma unroll 1
    for (int n = 0; n < 32; ++n) {
        const int p = n & 1; const size_t r0 = (size_t)b * SEQ + 64 * n;
        const LAS unsigned char* Sp = St0 + p * 34816; LAS unsigned char* Sn = St0 + (1 - p) * 34816;
        float uu[4][4]; dn2_load_u(P, F, bh, n, uu);
        u32x4 g0, g1; head_gate_load(F, (const bf16*)(ws + WS_T + T_Z) + r0 * NZ + 2560 + h * 128, g0, g1);
        dn2_load_b(P, F, bh, n, ob);
        dn2_load_a(P, F, bh, n + 1 < 32 ? n + 1 : n, nxt);
        f32x4 va[4];
#pragma unroll
        for (int t = 0; t < 4; ++t) { const int nt = ntb + t; f32x4 a = (f32x4){0.f, 0.f, 0.f, 0.f};
#pragma unroll
            for (int ks = 0; ks < 4; ++ks) a = MFMA16(cur.wf[ks], frag_row(Sp, 272, 16 * nt, 32 * ks, lane), a);
            va[t] = a; }
        if (n > 0) { f32x4 nwv[4]; const int seg = F.tid & 7;
#pragma unroll
            for (int q = 0; q < 4; ++q) nwv[q] = *(const LAS f32x4*)(nws + 16 * seg + 4 * q);
            head_norm_store<0>(F, Os, nwv, gp0, gp1, MIX + (r0 - 64) * D + h * 128); }
#pragma unroll
        for (int t = 0; t < 4; ++t) { const int nt = ntb + t;
            *(LAS unsigned long long*)(VnT + (16 * nt + c) * 144 + (16 * mt + 4 * rq) * 2) = (unsigned long long)pk2(uu[t][0] - va[t][0], uu[t][1] - va[t][1]) | ((unsigned long long)pk2(uu[t][2] - va[t][2], uu[t][3] - va[t][3]) << 32); }
        lds_barrier();
#pragma unroll
        for (int t = 0; t < 4; ++t) { const int nt = ntb + t; f32x4 a = (f32x4){0.f, 0.f, 0.f, 0.f};
#pragma unroll
            for (int ks = 0; ks < 4; ++ks) a = MFMA16(ob.qf[ks], frag_row(Sp, 272, 16 * nt, 32 * ks, lane), a);
#pragma unroll
            for (int ks = 0; ks < 2; ++ks) a = MFMA16(ob.af[ks], frag_row(VnT, 144, 16 * nt, 32 * ks, lane), a);
#pragma unroll
            for (int e = 0; e < 4; ++e) Os[(16 * mt + 4 * rq + e) * 132 + 16 * nt + c] = a[e]; }
#pragma unroll
        for (int nt = 0; nt < 8; ++nt) { f32x4 a = sreg[nt] * ob.gl;
#pragma unroll
            for (int ks = 0; ks < 2; ++ks) a = MFMA16(ob.kf[ks], frag_row(VnT, 144, 16 * nt, 32 * ks, lane), a);
            sreg[nt] = a;
            *(LAS unsigned long long*)(Sn + (16 * nt + c) * 272 + (16 * w + 4 * rq) * 2) = (unsigned long long)pk2(a[0], a[1]) | ((unsigned long long)pk2(a[2], a[3]) << 32); }
        lds_barrier();
        gp0 = g0; gp1 = g1; cur = nxt;
    }
    { f32x4 nwv[4]; const int seg = F.tid & 7;
#pragma unroll
      for (int q = 0; q < 4; ++q) nwv[q] = *(const LAS f32x4*)(nws + 16 * seg + 4 * q);
      head_norm_store<0>(F, Os, nwv, gp0, gp1, MIX + ((size_t)b * SEQ + 64 * 31) * D + h * 128); }
    __syncthreads();
}

DI void ml3_unit(const Params& P, const Frame& F, int L, int cidx) {
    unsigned char* ws = P.ws;
    const int bh = cidx >> 5, n = cidx & 31, b = bh >> 2, h = bh & 3; const size_t r0 = (size_t)b * SEQ + 64 * n;
    const bf16* Z = (const bf16*)(ws + WS_T + T_Z); const bf16* ZC = (const bf16*)(ws + WS_T + T_ZC); const float* MLS = (const float*)(ws + WS_MLS);
    const bf16* CST = (const bf16*)(ws + WS_T + T_CST) + (size_t)cidx * 18432; bf16* MIX = (bf16*)(ws + WS_T + T_MIX);
    LAS unsigned char* Qs = F.lds; LAS unsigned char* Ks = F.lds + 17408; LAS unsigned char* Vx = F.lds + 34816; LAS unsigned char* Cs = F.lds + 54272; LAS unsigned char* Sm = F.lds + 93440;
    LAS float* sA = (LAS float*)(F.lds + 102656); LAS float* ej = sA + 64; LAS float* inter = sA + 128; LAS float* flo = sA + 192; LAS float* den1 = sA + 256; LAS float* qn = sA + 320;
    LAS float* Hs = (LAS float*)F.lds;
    const int lane = F.lane, c = lane & 15, rq = lane >> 4, w = F.wave;
    for (int id = F.tid; id < 3072; id += NTHR) { const int which = id >> 10, rem = id & 1023, row = rem >> 4, ch = rem & 15;
        if (which == 0) *(LAS u32x4*)(Qs + row * 272 + ch * 16) = *(const u32x4*)(ZC + (r0 + row) * 2560 + 1536 + h * 128 + ch * 8);
        else if (which == 1) *(LAS u32x4*)(Ks + row * 272 + ch * 16) = *(const u32x4*)(ZC + (r0 + row) * 2560 + 2048 + h * 128 + ch * 8);
        else *(LAS u32x4*)(Vx + row * 304 + ch * 16) = *(const u32x4*)(Z + (r0 + row) * NZ + 6144 + h * 128 + ch * 8); }
    if (F.tid < 128) { const int row = F.tid >> 1, which = F.tid & 1; *(LAS u32x4*)(Vx + row * 304 + 256 + which * 16) = (u32x4){which == 0 ? 0x00003F80u : 0u, 0u, 0u, 0u}; }
    for (int id = F.tid; id < 2304; id += NTHR) { const int row = id >> 4, ch = id & 15; *(LAS u32x4*)(Cs + row * 272 + ch * 16) = *(const u32x4*)(CST + row * 128 + ch * 8); }
    if (F.tid < 64) { const float* s = MLS + ((r0 + F.tid) * 4 + h) * 8; ej[F.tid] = s[0]; sA[F.tid] = s[1]; inter[F.tid] = s[2]; flo[F.tid] = s[3]; }
    __syncthreads();
#pragma unroll
    for (int ti = 0; ti < 2; ++ti) { const int idx = 2 * w + ti, mt = idx >> 2, nt = idx & 3; f32x4 a = (f32x4){0.f, 0.f, 0.f, 0.f};
        if (mt >= nt) {
#pragma unroll
            for (int ks = 0; ks < 4; ++ks) a = MFMA16(frag_row(Qs, 272, 16 * mt, 32 * ks, lane), frag_row(Ks, 272, 16 * nt, 32 * ks, lane), a);
        }
        const int j = 16 * nt + c; const float e_j = ej[j];
#pragma unroll
        for (int e = 0; e < 4; ++e) { const int i = 16 * mt + 4 * rq + e; *(LAS bf16*)(Sm + i * 144 + j * 2) = (bf16)f2bf((i >= j) ? a[e] * __expf(sA[i] + e_j) : 0.f); } }
    const int mt = w >> 1, ntb = (w & 1) * 4;
    f32x4 acc2[4], acc1[4], a29 = (f32x4){0.f, 0.f, 0.f, 0.f}, a19 = (f32x4){0.f, 0.f, 0.f, 0.f};
    { bf16x8 qf[4];
#pragma unroll
      for (int ks = 0; ks < 4; ++ks) qf[ks] = frag_row(Qs, 272, 16 * mt, 32 * ks, lane);
#pragma unroll
      for (int t = 0; t < 4; ++t) { f32x4 a = (f32x4){0.f, 0.f, 0.f, 0.f};
#pragma unroll
          for (int ks = 0; ks < 4; ++ks) a = MFMA16(qf[ks], frag_row(Cs, 272, 16 * (ntb + t), 32 * ks, lane), a);
          acc2[t] = a; }
      if ((w & 1) == 0) {
#pragma unroll
          for (int ks = 0; ks < 4; ++ks) a29 = MFMA16(qf[ks], frag_row(Cs, 272, 128, 32 * ks, lane), a29); } }
    __syncthreads();
    { const unsigned Va = (unsigned)(size_t)Vx; bf16x8 sf[2];
#pragma unroll
      for (int ks = 0; ks < 2; ++ks) sf[ks] = frag_row(Sm, 144, 16 * mt, 32 * ks, lane);
#pragma unroll
      for (int t = 0; t < 4; ++t) { f32x4 a = (f32x4){0.f, 0.f, 0.f, 0.f};
#pragma unroll
          for (int ks = 0; ks < 2; ++ks) a = MFMA16(sf[ks], frag_tr(Va, 304, 32 * ks, 16 * (ntb + t), lane), a);
          acc1[t] = a; }
      if ((w & 1) == 0) {
#pragma unroll
          for (int ks = 0; ks < 2; ++ks) a19 = MFMA16(sf[ks], frag_tr(Va, 304, 32 * ks, 128, lane), a19);
          if (c == 0) {
#pragma unroll
              for (int e = 0; e < 4; ++e) { den1[16 * mt + 4 * rq + e] = a19[e]; qn[16 * mt + 4 * rq + e] = a29[e]; } } } }
    __syncthreads();
#pragma unroll
    for (int t = 0; t < 4; ++t)
#pragma unroll
        for (int e = 0; e < 4; ++e) { const int i = 16 * mt + 4 * rq + e; const float it = inter[i], den = den1[i] + it * qn[i];
            Hs[i * 132 + 16 * (ntb + t) + c] = (acc1[t][e] + it * acc2[t][e]) / fmaxf(fabsf(den), flo[i]); }
    __syncthreads();
    { u32x4 g0, g1; f32x4 nwv[4]; head_gate_load(F, Z + r0 * NZ + 6656 + h * 128, g0, g1); head_nw_load(F, P.in[I_ML_NORM] + L * 128, nwv); head_norm_store<1>(F, Hs, nwv, g0, g1, MIX + r0 * D + 1536 + h * 128); }
    __syncthreads();
}

constexpr int NPH = 28;
#ifndef MK_SPLIT
#define MK_SPLIT 0
#endif

#define PH_SETUP() { int l_ = __builtin_amdgcn_mbcnt_hi(~0u, __builtin_amdgcn_mbcnt_lo(~0u, 0u)); asm volatile("" : "+v"(l_)); F.lane = l_; F.tid = F.wave * 64 + l_; }
#define PH_BEGIN(k, kind) if (lo <= (k) && (k) < hi) { PH_SETUP()
#define PH_END(k) if ((k) + 1 < hi) xcd_barrier(bar); }
template <int L> DI void layer_phases(const Params& P, Frame& F, const XcdBarrier& bar, int lo, int hi) {
    unsigned char* ws = P.ws;
    LAS unsigned char* ring = F.lds;
    bf16* HN = (bf16*)(ws + WS_HN); bf16* H = (bf16*)(ws + WS_H);
        const int pb = 1 + 13 * L;
        const void* hin = (L == 0) ? (const void*)P.in[I_X] : (const void*)H;
        PH_BEGIN(pb + 0, 0) norm_phase<1, L == 1>(P, F, L, hin, P.in[I_ATTN_NORM] + L * D, false); PH_END(pb + 0)
        PH_BEGIN(pb + 1, 1) {
            const int gg = (L == 0) ? GRID - NCONV : GRID;
            if (F.bid < gg) {
                pg8::Gemm g{HN, (const bf16*)(ws + WS_WIN) + (size_t)L * NZ * D, M, NZ, D, 0, 0}; pg8::StaticOrder S; S.init(M, NZ, gg, F.bid);
                pg8::EpiBf16Plain E{(bf16*)(ws + WS_T + T_Z), NZ};
                pg8::gemm_phase<pg8::EpiBf16Plain, pg8::StaticOrder, true, true>(ring, g, S, E, F.wave); }
            else prologue_phase<1>(P, F); }
        PH_END(pb + 1)
        PH_BEGIN(pb + 2, 2) {
            prep_phase(P, F, L);
            static_assert(GRID * 64 == M && SEQ / 64 == 32, "one 64-row chunk per workgroup");
            Frame Hf = F; const int half = F.wave >> 2, cb = F.bid >> 5, cn = F.bid & 31; Hf.tid = F.tid & 255; Hf.wave = F.wave & 3;
            Hf.lds = F.lds + half * 69120;
#pragma unroll 1
            for (int hh = 0; hh < 2; ++hh) dn1_unit<4>(P, Hf, ((cb * 4 + 2 * half + hh) * 32 + cn));
            Hf.lds = F.lds + half * 35328;
#pragma unroll 1
            for (int hh = 0; hh < 2; ++hh) ml1_unit<4>(P, Hf, ((cb * 4 + 2 * half + hh) * 32 + cn)); }
        PH_END(pb + 2)
        PH_BEGIN(pb + 4, 4) {
            if (F.bid < 32) dn2_block(P, F, L, F.bid); else ml2_scan(P, (F.bid - 32) * NTHR + F.tid, (F.G - 32) * NTHR);
            const float li = (L == 0) ? 0.2f : 0.35550906759f;
            const float d1 = wave_sum(P.in[I_LQ1][L * 64 + F.lane] * P.in[I_LK1][L * 64 + F.lane]), d2 = wave_sum(P.in[I_LQ2][L * 64 + F.lane] * P.in[I_LK2][L * 64 + F.lane]);
            const float lam = __expf(d1) - __expf(d2) + li;
            unsigned* qctr = (unsigned*)(ws + WS_CTL) + CW_QUEUE + 64 * L;
            for (;;) {
                __syncthreads();
                if (F.tid == 0) F.MISC[24] = __hip_atomic_fetch_add(qctr, 1u, __ATOMIC_RELAXED, __HIP_MEMORY_SCOPE_AGENT);
                __syncthreads();
                const int u = (int)F.MISC[24];
                if (u >= 1024) break;
                const int bh = u & 63; attn_block(P, F, L, bh >> 3, bh & 7, 15 - (u >> 6), lam, 1.0f - li); } }
        PH_END(pb + 4)
        PH_BEGIN(pb + 5, 5) for (int u = F.bid; u < NCHUNK; u += F.G) ml3_unit(P, F, L, u); PH_END(pb + 5)
        PH_BEGIN(pb + 6, 6) {
            pg8::Gemm g{(const bf16*)(ws + WS_T + T_MIX), (const bf16*)(ws + WS_WOUT) + (size_t)L * D * D, M, D, D, 0, 0}; pg8::StaticOrder S; S.init(M, D, F.G, F.bid);
            pg8::EpiRes<1, L == 0> E{H, hin, nullptr, D};
            pg8::gemm_phase<pg8::EpiRes<1, L == 0>, pg8::StaticOrder, true, true>(ring, g, S, E, F.wave); }
        PH_END(pb + 6)
        if (L == 0) {
            PH_BEGIN(pb + 7, 7) norm_phase<0, true>(P, F, L, H, P.in[I_FFN_NORM] + L * D, false); PH_END(pb + 7)
            PH_BEGIN(pb + 9, 9) {
                pg8::Gemm g{HN, (const bf16*)(ws + WS_WGU), M, 2 * DFF, D, 0, 0}; pg8::StaticOrder S; S.init(M, 2 * DFF, F.G, F.bid);
                pg8::EpiSwiGLU<true> E{(unsigned char*)(ws + WS_T + T_ACT), DFF, (float)(1 << LS_ACT)};
                pg8::gemm_phase<pg8::EpiSwiGLU<true>, pg8::StaticOrder, true, true, false>(ring, g, S, E, F.wave); }
            PH_END(pb + 9)
            PH_BEGIN(pb + 10, 10) {
                pg8::Gemm g{(const bf16*)(ws + WS_T + T_ACT), (const bf16*)(ws + WS_WD), M, D, DFF / 2, SB(LS_ACT), SB(LS_WD)}; pg8::StaticOrder S; S.init(M, D, F.G, F.bid);
                pg8::EpiRes<1, false> E{H, H, nullptr, D};
                pg8::gemm_phase<pg8::EpiRes<1, false>, pg8::StaticOrder, true, true, true>(ring, g, S, E, F.wave); }
            PH_END(pb + 10)
        } else {
            PH_BEGIN(pb + 7, 7) norm_phase<2, true>(P, F, L, H, P.in[I_FFN_NORM] + L * D, false); PH_END(pb + 7)
            PH_BEGIN(pb + 8, 8) moe_gather_phase(P, F); PH_END(pb + 8)
            PH_BEGIN(pb + 9, 9) {
                const int* TILE_E = (const int*)(ws + WS_TILEE); const int ntile = __builtin_amdgcn_readfirstlane(TILE_E[255]);
                unsigned* mcnt = (unsigned*)(ws + WS_CTL) + CW_MOECNT;
                { pg8::Gemm g{(const bf16*)(ws + WS_T + T_APERM), (const bf16*)(ws + WS_MGU), ntile * 256, 2 * DFF, D / 2, SB(LS_HN), SB(LS_WGU)};
                  pg8::MoeGuOrder S; S.init(ntile * 256, 2 * DFF, F.G, F.bid); S.tile_e = TILE_E; S.estride = (size_t)2 * DFF * D;
                  const int nd = ntile * (D / 256), rmax = (nd + F.G - 1) / F.G; int Hh = nd - (rmax - 1) * F.G; if (Hh >= F.G) Hh = 0;
                  S.H = Hh; S.NL = F.G - Hh; S.gH = (S.nwg - 3 * S.NL) / F.G; if (S.gH < 0) S.gH = 0; S.cnt = mcnt; S.pend = -1; S.lead = (F.tid == 0);
                  pg8::EpiSwiGLU<true, true> E{(unsigned char*)(ws + WS_T + T_ACT), DFF, (float)(1 << LS_ACT)};
                  pg8::gemm_phase<pg8::EpiSwiGLU<true, true>, pg8::MoeGuOrder, true, true, true>(ring, g, S, E, F.wave);
                  S.flush(); }
                { pg8::Gemm g{(const bf16*)(ws + WS_T + T_ACT), (const bf16*)(ws + WS_MD), ntile * 256, D, DFF / 2, SB(LS_ACT), SB(LS_WD)};
                  pg8::MoeDnOrder S; S.init(ntile * 256, D, F.G, F.bid); S.tile_e = TILE_E; S.estride = (size_t)D * DFF;
                  S.cnt = mcnt; S.need = 2 * DFF / 256;
                  pg8::EpiBf16Plain E{(bf16*)(ws + WS_T + T_YPERM), D};
                  pg8::gemm_phase<pg8::EpiBf16Plain, pg8::MoeDnOrder, true, true, true>(ring, g, S, E, F.wave); } }
            PH_END(pb + 9)
        }
        PH_BEGIN(pb + 11, 11) norm_phase<3, true>(P, F, L, H, P.in[I_PLE_NORM] + L * D, L == 1); PH_END(pb + 11)
        PH_BEGIN(pb + 12, 12) {
            { int kple = PLE; asm volatile("" : "+s"(kple)); pg8::Gemm g{(const bf16*)(ws + WS_T + T_PB), (const bf16*)(ws + WS_WPP) + (size_t)L * D * PLE, M, D, kple, 0, 0}; pg8::StaticOrder S; S.init(M, D, F.G, F.bid);
              pg8::EpiBf16Plain E{(bf16*)(ws + WS_T + T_PP), D};
              pg8::gemm_phase<pg8::EpiBf16Plain, pg8::StaticOrder, true, true>(ring, g, S, E, F.wave); }
            { pg8::Gemm g{HN, (const bf16*)(ws + WS_WPG) + (size_t)L * D * D, M, D, L == 1 ? D / 2 : D, L == 1 ? SB(LS_HN) : 0, L == 1 ? SB(LS_WGU) : 0}; pg8::StaticOrder S; S.init(M, D, F.G, F.bid);
              pg8::EpiRes<2, false> E{H, H, (const bf16*)(ws + WS_T + T_PP), D};
              pg8::gemm_phase<pg8::EpiRes<2, false>, pg8::StaticOrder, true, true, L == 1>(ring, g, S, E, F.wave); } }
        PH_END(pb + 12)
    }
__global__ void __launch_bounds__(NTHR, 2) fwd(Params P) {
    extern __shared__ __attribute__((aligned(16))) unsigned char lds_raw[];
    Frame F;
    F.lds = (LAS unsigned char*)lds_raw;
    F.MISC = (volatile LAS unsigned*)(F.lds + MISC_OFF);
    F.tid = threadIdx.x; F.lane = F.tid & 63; F.wave = __builtin_amdgcn_readfirstlane(F.tid >> 6);
    F.G = GRID; F.bid = blockIdx.x;
    unsigned char* ws = P.ws;
    for (int u = F.tid; u < (LDS_BYTES - MISC_OFF) / 4; u += NTHR) ((LAS unsigned*)(F.lds + MISC_OFF))[u] = 0u;
    __syncthreads();
    XcdBarrier bar = xcd_barrier_post((unsigned*)(ws + WS_CTL) + CW_BAR, F.MISC + 8);
    const int lo = P.ph_lo, hi = P.ph_hi;
    LAS unsigned char* ring = F.lds;
    bf16* HN = (bf16*)(ws + WS_HN); bf16* H = (bf16*)(ws + WS_H);

    PH_BEGIN(0, 13) prologue_phase<0>(P, F); PH_END(0)

    layer_phases<0>(P, F, bar, lo, hi);
    layer_phases<1>(P, F, bar, lo, hi);
    PH_BEGIN(27, 14) norm_phase<4, true>(P, F, 0, H, P.in[I_FINAL_NORM], false); PH_END(27)
#undef PH_BEGIN
#undef PH_END
}

extern "C" void kernel_launch(void* const* d_in, const int* in_sizes, int n_in, void* d_out, int out_size, void* d_ws, size_t ws_size, hipStream_t stream) {
    static int grid = 0;
    if (grid == 0) {
        if (n_in != 30 || out_size != M * D || ws_size < WS_END) { fprintf(stderr, "kernel_launch: unexpected shapes (n_in %d out %d ws %zu, need %zu)\n", n_in, out_size, ws_size, (size_t)WS_END); grid = -1; return; }
        int dev = 0, cus = 0, per_cu = 0;
        if (hipGetDevice(&dev) != hipSuccess || hipDeviceGetAttribute(&cus, hipDeviceAttributeMultiprocessorCount, dev) != hipSuccess) { grid = -1; return; }
        if (hipFuncSetAttribute((const void*)fwd, hipFuncAttributeMaxDynamicSharedMemorySize, LDS_BYTES) != hipSuccess) { fprintf(stderr, "kernel_launch: hipFuncSetAttribute failed\n"); grid = -1; return; }
        if (hipOccupancyMaxActiveBlocksPerMultiprocessor(&per_cu, (const void*)fwd, NTHR, LDS_BYTES) != hipSuccess || per_cu < 1) fprintf(stderr, "kernel_launch: occupancy query says %d\n", per_cu);
        (void)hipGetLastError();
        grid = GRID;
    }
    if (grid < 0) return;
    (void)hipMemsetAsync((char*)d_ws + WS_CTL, 0, CTL_ZERO_BYTES, stream);
    Params p{};
    for (int i = 0; i < 30; ++i) p.in[i] = (const float*)d_in[i];
    p.out = (float*)d_out; p.ws = (unsigned char*)d_ws;
#if MK_SPLIT
    for (int k = 0; k < NPH; ++k) { if (k == 1 + 8) continue; p.ph_lo = k; p.ph_hi = k + 1; hipLaunchKernelGGL(fwd, dim3(grid), dim3(NTHR), LDS_BYTES, stream, p); }
#else
    p.ph_lo = 0; p.ph_hi = NPH; hipLaunchKernelGGL(fwd, dim3(grid), dim3(NTHR), LDS_BYTES, stream, p);
#endif
}
```

```cpp
#include <hip/hip_runtime.h>
#include <cstdio>
#include <cstdint>

#define DI __device__ __forceinline__
#define LAS __attribute__((address_space(3)))
#define GAS __attribute__((address_space(1)))
typedef unsigned short bf16;
typedef short bf16x8 __attribute__((ext_vector_type(8)));
typedef short s16x4 __attribute__((ext_vector_type(4)));
typedef float f32x4 __attribute__((ext_vector_type(4)));
typedef float f32x2 __attribute__((ext_vector_type(2)));
typedef unsigned u32x4 __attribute__((ext_vector_type(4)));
typedef unsigned u32x2 __attribute__((ext_vector_type(2)));

DI unsigned f2bf(float f) { unsigned u = __builtin_bit_cast(unsigned, f); return (u + 0x7fffu + ((u >> 16) & 1u)) >> 16; }
typedef __bf16 bf16x2_t __attribute__((ext_vector_type(2)));
DI unsigned pk2(float lo, float hi) { const f32x2 v = {lo, hi}; return __builtin_bit_cast(unsigned, __builtin_convertvector(v, bf16x2_t)); }
DI float bf2f(unsigned short b) { return __builtin_bit_cast(float, ((unsigned)b) << 16); }
DI float bflo(unsigned u) { return __builtin_bit_cast(float, u << 16); }
DI float bfhi(unsigned u) { return __builtin_bit_cast(float, u & 0xffff0000u); }
DI unsigned pk4_fp8(float a, float b, float c, float d) { unsigned w = 0u; w = __builtin_amdgcn_cvt_pk_fp8_f32(a, b, w, false); w = __builtin_amdgcn_cvt_pk_fp8_f32(c, d, w, true); return w; }
template <int K> DI float shx(float v) {
    if constexpr (K == 1) return __builtin_bit_cast(float, __builtin_amdgcn_update_dpp(0, __builtin_bit_cast(int, v), 0xB1, 0xF, 0xF, true));
    else if constexpr (K == 2) return __builtin_bit_cast(float, __builtin_amdgcn_update_dpp(0, __builtin_bit_cast(int, v), 0x4E, 0xF, 0xF, true));
    else if constexpr (K == 32) return __shfl_xor(v, 32);
    else return __builtin_bit_cast(float, __builtin_amdgcn_ds_swizzle(__builtin_bit_cast(int, v), (K << 10) | 0x1F));
}
DI float wave_sum(float v) { v += shx<1>(v); v += shx<2>(v); v += shx<4>(v); v += shx<8>(v); v += shx<16>(v); v += shx<32>(v); return v; }
DI float wave_max(float v) { v = fmaxf(v, shx<1>(v)); v = fmaxf(v, shx<2>(v)); v = fmaxf(v, shx<4>(v)); v = fmaxf(v, shx<8>(v)); v = fmaxf(v, shx<16>(v)); v = fmaxf(v, shx<32>(v)); return v; }
DI float sigmoidf_(float x) { return __builtin_amdgcn_rcpf(1.0f + __expf(-x)); }
DI float siluf_(float x) { return x * __builtin_amdgcn_rcpf(1.0f + __expf(-x)); }
DI float softplusf_(float x) { return fmaxf(x, 0.f) + log1pf(__expf(-fabsf(x))); }
DI void lds_barrier() { asm volatile("s_waitcnt lgkmcnt(0)" ::: "memory"); __builtin_amdgcn_s_barrier(); asm volatile("" ::: "memory"); }
#define LDS_WAIT() asm volatile("s_waitcnt lgkmcnt(0)" ::: "memory")
#define VM_WAIT() asm volatile("s_waitcnt vmcnt(0)" ::: "memory")

#define MK_SPLIT 0
namespace pg8 {
#define PG8_LAS __attribute__((address_space(3)))
typedef unsigned short bf16_t;
typedef short bf16x8 __attribute__((ext_vector_type(8)));
typedef float f32x4 __attribute__((ext_vector_type(4)));
typedef unsigned u32x4 __attribute__((ext_vector_type(4)));
constexpr int BM = 256, BK = 64, HALF = 128, HTB = HALF * BK * 2  , STAGE_BYTES = 8 * HTB, NXCD = 8, WGM = 8;

__host__ __device__ __forceinline__ int lds_byte(int r, int c) { const int st = (r >> 4) * 2 + (c >> 5), rr = r & 15, cc = c & 31, ob = rr * 64 + cc * 2; return st * 1024 + (ob ^ (((ob >> 9) & 1) << 5)); }
__host__ __device__ __forceinline__ void stage_rc(int b, int& R, int& C) { const int st = b / 1024, sb = b % 1024, swz = sb ^ (((sb >> 9) & 1) << 5); R = (st >> 1) * 16 + swz / 64; C = (st & 1) * 32 + (swz % 64) / 2; }
__host__ __device__ __forceinline__ int perm32(int rho) { const int n = rho >> 4, i = rho & 15; return 8 * (i >> 2) + 4 * n + (i & 3); }

struct Unit { int pm, pn; };
typedef int i32x8 __attribute__((ext_vector_type(8)));
struct Gemm { const bf16_t* A; const bf16_t* Bt; int M, N, K; int sa, sb; };

struct StaticOrder {
    int nM, nN, nwg, G, c;
    __host__ __device__ void init(int M, int N, int G_, int c_) { nM = M / BM; nN = N / BM; nwg = nM * nN; G = G_; c = c_; }
    __host__ __device__ bool next(int i, Unit& u) const { const int L = i * G + c; if (L >= nwg) return false; map(L, u); return true; }
    __host__ __device__ void map(int L, Unit& u) const {
        int wgid = L; { const int q = nwg / NXCD, r = nwg % NXCD, xcd = wgid % NXCD, off = wgid / NXCD; wgid = (xcd < r ? xcd * (q + 1) : r * (q + 1) + (xcd - r) * q) + off; }
        const int nig = WGM * nN, gid = wgid / nig, fm = gid * WGM, gsz = (nM - fm) < WGM ? (nM - fm) : WGM;
        u.pm = fm + ((wgid % nig) % gsz); u.pn = (wgid % nig) / gsz;
    }
    __device__ __forceinline__ size_t b_off(const Unit& u, size_t tstep) const { return (size_t)u.pn * tstep; }
    __device__ __forceinline__ void a_ready(const Unit&) const {}
    __device__ __forceinline__ void done(const Unit&) const {}
};

struct MoeOrder : StaticOrder {
    const int* tile_e; size_t estride;
    __device__ __forceinline__ size_t b_off(const Unit& u, size_t tstep) const { return (size_t)tile_e[u.pm] * estride + (size_t)u.pn * tstep; }
};
struct MoeGuOrder : MoeOrder {
    int gH, NL, H; unsigned* cnt; mutable int pend; bool lead;
    __device__ bool next(int i, Unit& u) const {
        int L; if (i < gH) L = i * G + c; else { if (c < H) return false; L = gH * G + (i - gH) * NL + (c - H); }
        if (L >= nwg) return false;
        const int ug = 8 * nN, g = L / ug, idx = L - g * ug, gsz = (nM - 8 * g) < 8 ? (nM - 8 * g) : 8, x = idx & 7, j = idx >> 3;
        u.pm = 8 * g + j % gsz; u.pn = x * (nN / 8) + j / gsz; return true; }
    __device__ __forceinline__ void done(const Unit& u) const { if (pend >= 0 && lead) __hip_atomic_fetch_add(cnt + 64 * pend, 1u, __ATOMIC_RELAXED, __HIP_MEMORY_SCOPE_AGENT); pend = u.pm; }
    __device__ __forceinline__ void flush() const { if (pend >= 0 && lead) __hip_atomic_fetch_add(cnt + 64 * pend, 1u, __ATOMIC_RELAXED, __HIP_MEMORY_SCOPE_AGENT); pend = -1; }
};
struct MoeDnOrder : MoeOrder {
    const unsigned* cnt; unsigned need;
    __device__ bool next(int i, Unit& u) const {
        const int L = i * G + c; if (L >= nwg) return false;
        const int ub = 32 * nN, band = L / ub, idx = L - band * ub, rows = (nM - 32 * band) < 32 ? (nM - 32 * band) : 32;
        if (rows == 32) { const int x = idx & 7, k = idx >> 3; u.pm = 32 * band + 8 * (x >> 1) + (k & 7); u.pn = (nN / 2) * (x & 1) + (k >> 3); }
        else { u.pm = 32 * band + idx / nN; u.pn = idx % nN; }
        return true; }
    __device__ __forceinline__ void a_ready(const Unit& u) const {
        unsigned* p = (unsigned*)cnt + 64 * u.pm; unsigned sp = 0;
        while ((unsigned)__builtin_amdgcn_readfirstlane((int)__hip_atomic_load(p, __ATOMIC_RELAXED, __HIP_MEMORY_SCOPE_AGENT)) < need) { __builtin_amdgcn_s_sleep(1); if (++sp > (1u << 21)) break; }
        __builtin_amdgcn_fence(__ATOMIC_ACQUIRE, "agent"); }
};
typedef float f32x2_ __attribute__((ext_vector_type(2))); typedef __bf16 bf16x2_ __attribute__((ext_vector_type(2)));
__device__ __forceinline__ unsigned cvt_pk_bf16(float lo, float hi) { const f32x2_ v = {lo, hi}; return __builtin_bit_cast(unsigned, __builtin_convertvector(v, bf16x2_)); }
struct EpiBf16Plain {
    static constexpr bool PERM = true, AFTER_DRAIN = false;
    bf16_t* O; int ldc;
    __device__ __forceinline__ void operator()(const f32x4 (&acc)[2][2][4][2], const Unit& u, int wr, int wc, int fr, int fq) const {
        const int row0 = u.pm * BM + wr * 64 + fr, col0 = u.pn * BM + wc * 32 + 8 * fq;
#pragma unroll
        for (int ai = 0; ai < 2; ++ai)
#pragma unroll
            for (int m = 0; m < 4; ++m) { bf16_t* rowp = O + (size_t)(row0 + ai * HALF + m * 16) * ldc + col0;
#pragma unroll
                for (int bj = 0; bj < 2; ++bj) { const f32x4 v0 = acc[ai][bj][m][0], v1 = acc[ai][bj][m][1];
                    u32x4 w; w.x = cvt_pk_bf16(v0[0], v0[1]); w.y = cvt_pk_bf16(v0[2], v0[3]); w.z = cvt_pk_bf16(v1[0], v1[1]); w.w = cvt_pk_bf16(v1[2], v1[3]);
                    *(u32x4*)(rowp + bj * HALF) = w; } }
    }
};
template <bool OUT8, bool WT = false  , bool RS = false  > struct EpiSwiGLU {
    static constexpr bool PERM = true, AFTER_DRAIN = false;
    unsigned char* O; int ldc; float oscale; const PG8_LAS float* rs;
    __device__ __forceinline__ void operator()(const f32x4 (&acc)[2][2][4][2], const Unit& u, int wr, int wc, int fr, int fq) const {
        const int row0 = u.pm * BM + wr * 64 + fr, col0 = u.pn * HALF + wc * 32 + 8 * fq;
        if constexpr (WT) {
            static_assert(OUT8, "write-through variant is fp8 only");
            const bool odd = fq & 1;
#pragma unroll
            for (int ai = 0; ai < 2; ++ai)
#pragma unroll
                for (int mp = 0; mp < 4; mp += 2) { unsigned w[2][2];
#pragma unroll
                    for (int mm = 0; mm < 2; ++mm) { float r[8];
#pragma unroll
                        for (int n = 0; n < 2; ++n)
#pragma unroll
                            for (int j = 0; j < 4; ++j) { const float g = acc[ai][0][mp + mm][n][j], up = acc[ai][1][mp + mm][n][j];
                                r[n * 4 + j] = __builtin_amdgcn_fmed3f(g * __builtin_amdgcn_rcpf(1.0f + __expf(-g)) * (up * oscale), -448.0f, 448.0f); }
                        unsigned w0 = 0u, w1 = 0u;
                        w0 = __builtin_amdgcn_cvt_pk_fp8_f32(r[0], r[1], w0, false); w0 = __builtin_amdgcn_cvt_pk_fp8_f32(r[2], r[3], w0, true);
                        w1 = __builtin_amdgcn_cvt_pk_fp8_f32(r[4], r[5], w1, false); w1 = __builtin_amdgcn_cvt_pk_fp8_f32(r[6], r[7], w1, true);
                        w[mm][0] = w0; w[mm][1] = w1; }
                    const unsigned sx = odd ? w[0][0] : w[1][0], sy = odd ? w[0][1] : w[1][1];
                    const unsigned rx = (unsigned)__builtin_amdgcn_ds_swizzle((int)sx, (16 << 10) | 0x1F), ry = (unsigned)__builtin_amdgcn_ds_swizzle((int)sy, (16 << 10) | 0x1F);
                    u32x4 o; o.x = odd ? rx : w[0][0]; o.y = odd ? ry : w[0][1]; o.z = odd ? w[1][0] : rx; o.w = odd ? w[1][1] : ry;
                    unsigned char* p = O + (size_t)(row0 + ai * HALF + (mp + (odd ? 1 : 0)) * 16) * ldc + (col0 - (odd ? 8 : 0));
                    asm volatile("global_store_dwordx4 %0, %1, off sc1\n\ts_nop 1" :: "v"(p), "v"(o) : "memory"); }
            return; }
#pragma unroll
        for (int ai = 0; ai < 2; ++ai)
#pragma unroll
            for (int m = 0; m < 4; ++m) { unsigned char* rowp = O + ((size_t)(row0 + ai * HALF + m * 16) * ldc + col0) * (OUT8 ? 1 : 2);
                float r[8]; float rr = 1.0f; if constexpr (RS) rr = rs[(row0 + ai * HALF + m * 16) & 2047];
#pragma unroll
                for (int n = 0; n < 2; ++n)
#pragma unroll
                    for (int j = 0; j < 4; ++j) { const float g = acc[ai][0][m][n][j] * rr, up = acc[ai][1][m][n][j] * rr; float t = g * __builtin_amdgcn_rcpf(1.0f + __expf(-g)) * (OUT8 ? up * oscale : up); if (OUT8) t = __builtin_amdgcn_fmed3f(t, -448.0f, 448.0f);
                        r[n * 4 + j] = t; }
                if constexpr (OUT8) { unsigned w0 = 0u, w1 = 0u;
                    w0 = __builtin_amdgcn_cvt_pk_fp8_f32(r[0], r[1], w0, false); w0 = __builtin_amdgcn_cvt_pk_fp8_f32(r[2], r[3], w0, true);
                    w1 = __builtin_amdgcn_cvt_pk_fp8_f32(r[4], r[5], w1, false); w1 = __builtin_amdgcn_cvt_pk_fp8_f32(r[6], r[7], w1, true);
                    *(unsigned long long*)rowp = (unsigned long long)w0 | ((unsigned long long)w1 << 32); }
                else { u32x4 w; w.x = cvt_pk_bf16(r[0], r[1]); w.y = cvt_pk_bf16(r[2], r[3]); w.z = cvt_pk_bf16(r[4], r[5]); w.w = cvt_pk_bf16(r[6], r[7]); *(u32x4*)rowp = w; } }
    }
};
template <int MODE, bool RF32, bool EMIT = false, bool RS = false> struct EpiRes {
    static constexpr bool PERM = true, AFTER_DRAIN = false;
    bf16_t* C; const void* R; const bf16_t* P; int ld; float* SS; PG8_LAS float* part; const PG8_LAS float* rs;
    static __device__ __forceinline__ float lo_(unsigned u) { return __builtin_bit_cast(float, u << 16); }
    static __device__ __forceinline__ float hi_(unsigned u) { return __builtin_bit_cast(float, u & 0xffff0000u); }
    __device__ __forceinline__ void operator()(const f32x4 (&acc)[2][2][4][2], const Unit& u, int wr, int wc, int fr, int fq) const {
        const int row0 = u.pm * BM + wr * 64 + fr, col0 = u.pn * BM + wc * 32 + 8 * fq;
        constexpr int MB = (MODE == 2 || RF32) ? 2 : 4;
#pragma unroll
        for (int ai = 0; ai < 2; ++ai)
#pragma unroll
            for (int m0 = 0; m0 < 4; m0 += MB) {
                u32x4 rb[MB][2], pb[MB][2]; f32x4 rf[MB][2][2];
#pragma unroll
                for (int mm = 0; mm < MB; ++mm)
#pragma unroll
                    for (int bj = 0; bj < 2; ++bj) { const size_t off = (size_t)(row0 + ai * HALF + (m0 + mm) * 16) * ld + col0 + bj * HALF;
                        if constexpr (RF32) { rf[mm][bj][0] = *(const f32x4*)((const float*)R + off); rf[mm][bj][1] = *(const f32x4*)((const float*)R + off + 4); }
                        else rb[mm][bj] = *(const u32x4*)((const bf16_t*)R + off);
                        if constexpr (MODE == 2) pb[mm][bj] = *(const u32x4*)(P + off); }
#pragma unroll
                for (int mm = 0; mm < MB; ++mm) { float ssum = 0.f; float rr = 1.0f; if constexpr (RS) rr = rs[(row0 + ai * HALF + (m0 + mm) * 16) & 2047];
#pragma unroll
                    for (int bj = 0; bj < 2; ++bj) { const size_t off = (size_t)(row0 + ai * HALF + (m0 + mm) * 16) * ld + col0 + bj * HALF;
                        f32x4 r0, r1;
                        if constexpr (RF32) { r0 = rf[mm][bj][0]; r1 = rf[mm][bj][1]; }
                        else { const u32x4 w = rb[mm][bj]; r0 = (f32x4){lo_(w.x), hi_(w.x), lo_(w.y), hi_(w.y)}; r1 = (f32x4){lo_(w.z), hi_(w.z), lo_(w.w), hi_(w.w)}; }
                        f32x4 v0 = acc[ai][bj][m0 + mm][0], v1 = acc[ai][bj][m0 + mm][1]; if constexpr (RS) { v0 = v0 * rr; v1 = v1 * rr; }
                        if constexpr (MODE == 2) { const u32x4 w = pb[mm][bj]; const f32x4 p0 = {lo_(w.x), hi_(w.x), lo_(w.y), hi_(w.y)}, p1 = {lo_(w.z), hi_(w.z), lo_(w.w), hi_(w.w)};
#pragma unroll
                            for (int j = 0; j < 4; ++j) { v0[j] = p0[j] * __builtin_amdgcn_rcpf(1.0f + __expf(-v0[j])); v1[j] = p1[j] * __builtin_amdgcn_rcpf(1.0f + __expf(-v1[j])); } }
                        v0 = v0 + r0; v1 = v1 + r1;
                        u32x4 o; o.x = cvt_pk_bf16(v0[0], v0[1]); o.y = cvt_pk_bf16(v0[2], v0[3]); o.z = cvt_pk_bf16(v1[0], v1[1]); o.w = cvt_pk_bf16(v1[2], v1[3]);
                        *(u32x4*)(C + off) = o;
                        if constexpr (EMIT) { const float a0 = lo_(o.x), a1 = hi_(o.x), a2 = lo_(o.y), a3 = hi_(o.y), a4 = lo_(o.z), a5 = hi_(o.z), a6 = lo_(o.w), a7 = hi_(o.w);
                            ssum += ((a0 * a0 + a1 * a1) + (a2 * a2 + a3 * a3)) + ((a4 * a4 + a5 * a5) + (a6 * a6 + a7 * a7)); } }
                    if constexpr (EMIT) {
                        ssum += __builtin_bit_cast(float, __builtin_amdgcn_ds_swizzle(__builtin_bit_cast(int, ssum), (16 << 10) | 0x1F)); ssum += __shfl_xor(ssum, 32);
                        if (fq == 0) part[(ai * HALF + wr * 64 + (m0 + mm) * 16 + fr) * 4 + wc] = ssum; } }
                asm volatile("" ::: "memory"); }
        if constexpr (EMIT) {
            asm volatile("s_waitcnt lgkmcnt(0)\n\ts_barrier" ::: "memory");
            const int t = (wr * 4 + wc) * 64 + fq * 16 + fr;
            if (t < BM) { const f32x4 pz = *(const PG8_LAS f32x4*)(part + t * 4); SS[(size_t)(u.pm * BM + t) * 8 + u.pn] = (pz[0] + pz[1]) + (pz[2] + pz[3]); } }
    }
};
template <int MODE  > struct EpiF32 {
    static constexpr bool PERM = false, AFTER_DRAIN = false;
    float* C; const float* R; const float* P; int ldc, ldr, ldp;
    __device__ __forceinline__ void operator()(const f32x4 (&acc)[2][2][4][2], const Unit& u, int wr, int wc, int fr, int fq) const {
        const int row0 = u.pm * BM + wr * 64 + fr, col0 = u.pn * BM + wc * 32 + 4 * fq;
        constexpr int MB = (MODE == 2) ? 2 : 4;
#pragma unroll
        for (int ai = 0; ai < 2; ++ai)
#pragma unroll
            for (int m0 = 0; m0 < 4; m0 += MB) {
                f32x4 rv[MB][4], pv[MB][4];
                if (MODE >= 1) {
#pragma unroll
                    for (int mm = 0; mm < MB; ++mm) { const size_t rr = (size_t)(row0 + ai * HALF + (m0 + mm) * 16) * ldr + col0, rp = (size_t)(row0 + ai * HALF + (m0 + mm) * 16) * ldp + col0;
#pragma unroll
                        for (int q = 0; q < 4; ++q) { rv[mm][q] = *(const f32x4*)(R + rr + (q >> 1) * HALF + (q & 1) * 16); if (MODE == 2) pv[mm][q] = *(const f32x4*)(P + rp + (q >> 1) * HALF + (q & 1) * 16); } } }
#pragma unroll
                for (int mm = 0; mm < MB; ++mm) { const int m = m0 + mm; const size_t ro = (size_t)(row0 + ai * HALF + m * 16) * ldc + col0;
#pragma unroll
                    for (int q = 0; q < 4; ++q) { f32x4 v = acc[ai][q >> 1][m][q & 1];
                        if (MODE == 1) v = v + rv[mm][q];
                        if (MODE == 2) { f32x4 s;
#pragma unroll
                            for (int j = 0; j < 4; ++j) s[j] = pv[mm][q][j] * __builtin_amdgcn_rcpf(1.0f + __expf(-v[j]));
                            v = rv[mm][q] + s; }
                        *(f32x4*)(C + ro + (q >> 1) * HALF + (q & 1) * 16) = v; } }
                asm volatile("" ::: "memory"); }
    }
};


template <class Epi, class Sched, bool ALIGN_EPI = false, bool SP2 = false, bool F8 = false  >
__device__ __forceinline__ void gemm_phase(PG8_LAS unsigned char* lds, const Gemm g, const Sched& S, const Epi& E, const int wid_  ) {
    int tid = __builtin_amdgcn_mbcnt_hi(~0u, __builtin_amdgcn_mbcnt_lo(~0u, 0u)); asm volatile("" : "+v"(tid)); tid += wid_ * 64;
    const int wid = __builtin_amdgcn_readfirstlane(tid >> 6), lane = tid & 63, wr = wid >> 2, wc = wid & 3, fr = lane & 15, fq = lane >> 4;
    const int K = g.K, nt = K / BK;
    unsigned voffA[2], voffB[2];
#pragma unroll
    for (int i = 0; i < 2; ++i) { int R, C; stage_rc(tid * 16 + i * 8192, R, C); const int Rb = Epi::PERM ? ((R & ~31) + perm32(R & 31)) : R;
        voffA[i] = (unsigned)(R * K + C) * 2u; voffB[i] = (unsigned)(Rb * K + C) * 2u; }
    const unsigned kstep = (unsigned)(BK * 2);
    const unsigned hstep = (unsigned)HALF * (unsigned)K * 2u;
    const unsigned tstep = 2u * hstep;
    const unsigned ldsw = (unsigned)wid * 1024u;
    const int aoff = lds_byte(wr * 64 + fr, fq * 8), boff = lds_byte(wc * 32 + fr, fq * 8);
#define PG8_SA(b, h) (((b) * 2 + (h)) * HTB)
#define PG8_SB(b, h) ((4 + (b) * 2 + (h)) * HTB)
    const __amdgpu_buffer_rsrc_t rsrc_voffA = __builtin_amdgcn_make_buffer_rsrc((void*)g.A, 0, 0xFFFFFFFF, 0x00020000), rsrc_voffB = __builtin_amdgcn_make_buffer_rsrc((void*)g.Bt, 0, 0xFFFFFFFF, 0x00020000);
#define PG8_STAGE(bufoff, goff, voff) do { _Pragma("unroll") for (int _i = 0; _i < 2; ++_i) \
        __builtin_amdgcn_raw_ptr_buffer_load_lds(rsrc_##voff, (PG8_LAS unsigned*)(lds + (bufoff) + ldsw + _i * 8192), 16, (int)(voff)[_i], (int)(goff), 0, 0); } while (0)
#define PG8_LDA(dst, b, h) do { _Pragma("unroll") for (int m = 0; m < 4; ++m) _Pragma("unroll") for (int k = 0; k < 2; ++k) dst[m][k] = *(const PG8_LAS bf16x8*)(lds + PG8_SA(b, h) + aoff + m * 2048 + k * 1024); } while (0)
#define PG8_LDB(dst, b, h) do { _Pragma("unroll") for (int n = 0; n < 2; ++n) _Pragma("unroll") for (int k = 0; k < 2; ++k) dst[n][k] = *(const PG8_LAS bf16x8*)(lds + PG8_SB(b, h) + boff + n * 2048 + k * 1024); } while (0)
#define PG8_MMA(ai, bj, At, Bt) do { __builtin_amdgcn_s_setprio(1); _Pragma("unroll") for (int m = 0; m < 4; ++m) _Pragma("unroll") for (int n = 0; n < 2; ++n) { \
        if constexpr (F8) { const i32x8 a8_ = __builtin_bit_cast(i32x8, __builtin_shufflevector(At[m][0], At[m][1], 0, 1, 2, 3, 4, 5, 6, 7, 8, 9, 10, 11, 12, 13, 14, 15)); \
            const i32x8 b8_ = __builtin_bit_cast(i32x8, __builtin_shufflevector(Bt[n][0], Bt[n][1], 0, 1, 2, 3, 4, 5, 6, 7, 8, 9, 10, 11, 12, 13, 14, 15)); \
            acc[ai][bj][m][n] = __builtin_amdgcn_mfma_scale_f32_16x16x128_f8f6f4(b8_, a8_, acc[ai][bj][m][n], 0, 0, 0, g.sb, 0, g.sa); } \
        else { _Pragma("unroll") for (int k = 0; k < 2; ++k) acc[ai][bj][m][n] = __builtin_amdgcn_mfma_f32_16x16x32_bf16(Bt[n][k], At[m][k], acc[ai][bj][m][n], 0, 0, 0); } } \
        __builtin_amdgcn_s_setprio(0); } while (0)
#define PG8_WAIT_V(n) asm volatile("s_waitcnt vmcnt(" #n ")" ::: "memory")
#define PG8_WAIT_L(n) asm volatile("s_waitcnt lgkmcnt(" #n ")" ::: "memory")
#define PG8_BAR __builtin_amdgcn_s_barrier()
#define PG8_SCHED __builtin_amdgcn_sched_barrier(0)
    Unit cur, nxt; int ui = 0;
    if (!S.next(0, cur)) return;
    f32x4 acc[2][2][4][2];
#pragma unroll
    for (int a = 0; a < 2; ++a)
#pragma unroll
        for (int b = 0; b < 2; ++b)
#pragma unroll
            for (int m = 0; m < 4; ++m)
#pragma unroll
                for (int n = 0; n < 2; ++n) acc[a][b][m][n] = (f32x4){0.f, 0.f, 0.f, 0.f};
    bf16x8 At[4][2], B0[2][2], B1[2][2];
    unsigned cA = (unsigned)cur.pm * tstep, cB = (unsigned)S.b_off(cur, tstep);
    S.a_ready(cur);
    if constexpr (SP2) {
        PG8_STAGE(PG8_SB(0, 0), cB, voffB); PG8_STAGE(PG8_SB(0, 1), cB + hstep, voffB); PG8_STAGE(PG8_SA(0, 0), cA, voffA); PG8_STAGE(PG8_SA(0, 1), cA + hstep, voffA);
        if (wr == 1) PG8_BAR;
        PG8_WAIT_V(2); PG8_BAR;
        PG8_STAGE(PG8_SB(1, 0), cB + kstep, voffB); PG8_STAGE(PG8_SA(1, 0), cA + kstep, voffA); PG8_STAGE(PG8_SB(1, 1), cB + hstep + kstep, voffB);
        PG8_WAIT_V(6); PG8_BAR;
    } else {
        PG8_STAGE(PG8_SB(0, 0), cB, voffB); PG8_STAGE(PG8_SA(0, 0), cA, voffA); PG8_STAGE(PG8_SB(0, 1), cB + hstep, voffB); PG8_STAGE(PG8_SA(0, 1), cA + hstep, voffA);
        if (wr == 1) PG8_BAR;
        PG8_WAIT_V(4); PG8_BAR;
        PG8_STAGE(PG8_SB(1, 0), cB + kstep, voffB); PG8_STAGE(PG8_SA(1, 0), cA + kstep, voffA); PG8_STAGE(PG8_SB(1, 1), cB + hstep + kstep, voffB);
        PG8_WAIT_V(6); PG8_BAR;
    }
    for (;;) {
        const bool has_next = S.next(ui + 1, nxt);
        const unsigned nA = has_next ? (unsigned)nxt.pm * tstep : cA, nB = has_next ? (unsigned)S.b_off(nxt, tstep) : cB;
        for (int t = 0; t < nt; t += 2) {
            const bool last = (t == nt - 2);
            const unsigned a1 = cA + (unsigned)(t + 1) * kstep;
            const unsigned a2 = last ? nA : cA + (unsigned)(t + 2) * kstep, b2 = last ? nB : cB + (unsigned)(t + 2) * kstep;
            const unsigned a3 = a2 + kstep, b3 = b2 + kstep;
            if (last && has_next) S.a_ready(nxt);
            if constexpr (SP2) {
            PG8_LDB(B0, 0, 0); PG8_LDB(B1, 0, 1); PG8_SCHED; PG8_LDA(At, 0, 0); PG8_STAGE(PG8_SA(1, 1), a1 + hstep, voffA);
            PG8_WAIT_V(8); PG8_WAIT_L(0); PG8_BAR; PG8_MMA(0, 0, At, B0); PG8_MMA(0, 1, At, B1); PG8_BAR; PG8_SCHED;
            PG8_LDA(At, 0, 1); PG8_STAGE(PG8_SB(0, 0), b2, voffB); PG8_STAGE(PG8_SB(0, 1), b2 + hstep, voffB); PG8_STAGE(PG8_SA(0, 0), a2, voffA);
            PG8_WAIT_V(8); PG8_WAIT_L(0); PG8_BAR; PG8_MMA(1, 0, At, B0); PG8_MMA(1, 1, At, B1); PG8_BAR; PG8_SCHED;
            PG8_LDB(B0, 1, 0); PG8_LDB(B1, 1, 1); PG8_SCHED; PG8_LDA(At, 1, 0); PG8_STAGE(PG8_SA(0, 1), a2 + hstep, voffA);
            PG8_WAIT_V(8); PG8_WAIT_L(0); PG8_BAR; PG8_MMA(0, 0, At, B0); PG8_MMA(0, 1, At, B1); PG8_BAR; PG8_SCHED;
            PG8_LDA(At, 1, 1); PG8_STAGE(PG8_SB(1, 0), b3, voffB); PG8_STAGE(PG8_SB(1, 1), b3 + hstep, voffB); PG8_STAGE(PG8_SA(1, 0), a3, voffA);
            PG8_WAIT_V(8); PG8_WAIT_L(0); PG8_BAR; PG8_MMA(1, 0, At, B0); PG8_MMA(1, 1, At, B1); PG8_BAR; PG8_SCHED;
            } else {
            PG8_LDB(B0, 0, 0); PG8_SCHED; PG8_LDA(At, 0, 0); PG8_STAGE(PG8_SA(1, 1), a1 + hstep, voffA);
            PG8_WAIT_L(8); PG8_BAR; PG8_WAIT_L(0); PG8_MMA(0, 0, At, B0); PG8_BAR; PG8_SCHED;
            PG8_LDB(B1, 0, 1); PG8_STAGE(PG8_SB(0, 0), b2, voffB);
            PG8_BAR; PG8_WAIT_L(0); PG8_MMA(0, 1, At, B1); PG8_BAR;
            PG8_LDA(At, 0, 1); PG8_STAGE(PG8_SA(0, 0), a2, voffA);
            PG8_BAR; PG8_WAIT_L(0); PG8_MMA(1, 0, At, B0); PG8_BAR; PG8_SCHED;
            PG8_STAGE(PG8_SB(0, 1), b2 + hstep, voffB);
            PG8_WAIT_V(6); PG8_BAR; PG8_MMA(1, 1, At, B1); PG8_BAR;
            PG8_LDB(B0, 1, 0); PG8_SCHED; PG8_LDA(At, 1, 0); PG8_STAGE(PG8_SA(0, 1), a2 + hstep, voffA);
            PG8_WAIT_L(8); PG8_BAR; PG8_WAIT_L(0); PG8_MMA(0, 0, At, B0); PG8_BAR; PG8_SCHED;
            PG8_LDB(B1, 1, 1); PG8_STAGE(PG8_SB(1, 0), b3, voffB);
            PG8_BAR; PG8_WAIT_L(0); PG8_MMA(0, 1, At, B1); PG8_BAR;
            PG8_LDA(At, 1, 1); PG8_STAGE(PG8_SA(1, 0), a3, voffA);
            PG8_BAR; PG8_WAIT_L(0); PG8_MMA(1, 0, At, B0); PG8_BAR; PG8_SCHED;
            PG8_STAGE(PG8_SB(1, 1), b3 + hstep, voffB);
            PG8_WAIT_V(6); PG8_BAR; PG8_MMA(1, 1, At, B1); PG8_BAR;
            }
        }
        if constexpr (ALIGN_EPI) { if (wr == 0) PG8_BAR; }
        if constexpr (!Epi::AFTER_DRAIN) { int le_ = __builtin_amdgcn_mbcnt_hi(~0u, __builtin_amdgcn_mbcnt_lo(~0u, 0u)); asm volatile("" : "+v"(le_));
            E(acc, cur, wr, wc, le_ & 15, le_ >> 4); S.done(cur); }
        if (!has_next) break;
#pragma unroll
        for (int a = 0; a < 2; ++a)
#pragma unroll
            for (int b = 0; b < 2; ++b)
#pragma unroll
                for (int m = 0; m < 4; ++m)
#pragma unroll
                    for (int n = 0; n < 2; ++n) acc[a][b][m][n] = (f32x4){0.f, 0.f, 0.f, 0.f};
        cur = nxt; cA = nA; cB = nB; ++ui;
        if constexpr (ALIGN_EPI) { if (wr == 1) PG8_BAR; }
    }
    PG8_WAIT_V(0);
    if constexpr (!ALIGN_EPI) { if (wr == 0) PG8_BAR; }
    PG8_BAR;
    if constexpr (Epi::AFTER_DRAIN) { E.fused(acc, cur, wr, wc, fr, fq, lds, wid, lane); S.done(cur); }
#undef PG8_SA
#undef PG8_SB
#undef PG8_STAGE
#undef PG8_LDA
#undef PG8_LDB
#undef PG8_MMA
#undef PG8_WAIT_V
#undef PG8_WAIT_L
#undef PG8_BAR
#undef PG8_SCHED
}
}
#define XB_TMO      128
#define XB_XCNT(j)  (256  + 64 * (j))
#define XB_XSUB(j)  (1280 + 64 * (j))
#define XB_XGEN(j)  (2304 + 64 * (j))
#define XB_TOP      3328
#define XB_TOPGEN   3392
#define XCD_BAR_WORDS 3456
#define XB_SPIN_CAP (1u << 18)

__device__ __forceinline__ unsigned xb_ld(unsigned* p)              { return __hip_atomic_load(p, __ATOMIC_RELAXED, __HIP_MEMORY_SCOPE_AGENT); }
__device__ __forceinline__ unsigned xb_add(unsigned* p, unsigned v) { return __hip_atomic_fetch_add(p, v, __ATOMIC_RELAXED, __HIP_MEMORY_SCOPE_AGENT); }
__device__ __forceinline__ unsigned xb_xcc_id() { return (unsigned)__builtin_amdgcn_s_getreg((3 << 11) | 20) & 0xFu; }
#define XB_SPIN(cond, bar) do { unsigned _sp = 0; while (cond) { __builtin_amdgcn_s_sleep(1); \
    if ((++_sp & 255u) == 0u) { if (xb_ld(&(bar)[XB_TMO])) break; if (_sp > XB_SPIN_CAP) { atomicAdd(&(bar)[XB_TMO], 1u); break; } } } } while (0)

struct XcdBarrier {
    unsigned* bar; unsigned x;
    volatile LAS unsigned* st;
};

__device__ __forceinline__ XcdBarrier xcd_barrier_post(unsigned* bar, volatile LAS unsigned* st) {
    XcdBarrier b; b.bar = bar; b.x = xb_xcc_id(); b.st = st;
    if (threadIdx.x == 0) (void)xb_add(&bar[XB_XCNT(b.x)], 1u);
    return b;
}
__device__ __forceinline__ void xcd_barrier_complete(unsigned* bar, unsigned x, unsigned& nloc, unsigned& nx) {
    const unsigned G = gridDim.x * gridDim.y * gridDim.z;
    unsigned sum, cnt, mine, sp = 0u;
    for (;;) {
        sum = 0u; cnt = 0u; mine = 0u;
#pragma unroll
        for (unsigned j = 0; j < 16; ++j) { const unsigned c = xb_ld(&bar[XB_XCNT(j)]); sum += c; cnt += (c > 0u) ? 1u : 0u; mine = (j == x) ? c : mine; }
        if (sum == G) break;
        __builtin_amdgcn_s_sleep(1);
        if ((++sp & 255u) == 0u) { if (xb_ld(&bar[XB_TMO])) break; if (sp > XB_SPIN_CAP) { atomicAdd(&bar[XB_TMO], 1u); break; } }
    }
    nloc = mine > 0u ? mine : 1u; nx = cnt > 0u ? cnt : 1u;
}

__device__ __forceinline__ void xcd_barrier(const XcdBarrier& b) {
    asm volatile("s_waitcnt vmcnt(0)" ::: "memory");
    __syncthreads();
    if (threadIdx.x == 0) {
        unsigned* bar = b.bar;
        __builtin_amdgcn_s_waitcnt(0);
        unsigned nloc = b.st[0], nx = b.st[1];
        if (nloc == 0u) { xcd_barrier_complete(bar, b.x, nloc, nx); b.st[0] = nloc; b.st[1] = nx; }
        const unsigned old = xb_add(&bar[XB_XSUB(b.x)], 1u);
        const unsigned gen = old / nloc;
        if (old + 1u == (gen + 1u) * nloc) {
            __builtin_amdgcn_fence(__ATOMIC_RELEASE, "agent");
            asm volatile("s_waitcnt vmcnt(0)" ::: "memory");
            const unsigned og = xb_add(&bar[XB_TOP], 1u);
            const unsigned tg = og / nx;
            if (og + 1u == (tg + 1u) * nx) xb_add(&bar[XB_TOPGEN], 1u);
            else XB_SPIN(xb_ld(&bar[XB_TOPGEN]) == tg, bar);
            __builtin_amdgcn_fence(__ATOMIC_ACQUIRE, "agent");
            xb_add(&bar[XB_XGEN(b.x)], 1u);
            asm volatile("s_waitcnt vmcnt(0)" ::: "memory");
        } else {
            XB_SPIN(xb_ld(&bar[XB_XGEN(b.x)]) == gen, bar);
            __builtin_amdgcn_fence(__ATOMIC_ACQUIRE, "agent");
            asm volatile("s_waitcnt vmcnt(0)" ::: "memory");
        }
    }
    __syncthreads();
}

constexpr int NWAVES = 8, NTHR = 512, GRID = 256;
constexpr int M = 16384, D = 2048, SEQ = 2048, NBATCH = 8, NZ = 7168, NIN = 7184, DFF = 7168, NEXP = 8, PLE = 256;
constexpr int NCHUNK = 1024;
constexpr int NCONV = 118;
constexpr float EPS = 1e-6f;
constexpr int LS_HN = 2, LS_WGU = 5, LS_ACT = 3, LS_WD = 6;
constexpr int SB(int l) { return (127 - l) * 0x01010101; }
constexpr int MAXPT = 136;
constexpr size_t MiB = 1u << 20;
constexpr size_t WS_CTL = 0, CTL_ZERO_BYTES = 1 * MiB;
constexpr size_t WS_WGT = 1 * MiB;
constexpr size_t WS_WRT = WS_WGT + 256 * 1024;
constexpr size_t WS_GD = 2 * MiB, WS_MLS = 3 * MiB, WS_MLCS = 5 * MiB  , WS_DNGL = 5 * MiB + 16384;
constexpr size_t WS_TOPE = 6 * MiB, WS_TOPW = WS_TOPE + 128 * 1024, WS_SLOT = WS_TOPW + 128 * 1024, WS_BLKCNT = WS_SLOT + 128 * 1024, WS_TILEE = WS_BLKCNT + 64 * 1024;
constexpr size_t WS_WIN = 8 * MiB, WS_WOUT = 64 * MiB, WS_WGU = 80 * MiB, WS_WD = 136 * MiB, WS_WPG = 164 * MiB, WS_WPP = 180 * MiB, WS_MGU = 182 * MiB, WS_MD = 630 * MiB;
constexpr size_t WS_H = 854 * MiB, WS_HN = 982 * MiB, WS_T = 1046 * MiB, WS_END = (1046 + 748) * MiB;
constexpr size_t T_Z = 0, T_ZC = 224 * MiB, T_U = 304 * MiB, T_W = 336 * MiB, T_QG = 368 * MiB, T_KGT = 384 * MiB, T_ATT = 400 * MiB, T_DCT = 408 * MiB, T_CST = 474 * MiB, T_MIX = 510 * MiB;
constexpr size_t T_ACT = 0, T_APERM = 476 * MiB, T_YPERM = 612 * MiB, T_PB = 0, T_PP = 16 * MiB;
constexpr size_t T_PB0 = 576 * MiB, T_SS = 584 * MiB;
constexpr int CW_TMO = 0;
constexpr int CW_QUEUE = 2048;
constexpr int CW_MOECNT = 16384;
constexpr int CW_BAR = 4096;
constexpr int RING_BYTES = 131072;
constexpr int MISC_OFF = 139264;
constexpr int LDS_RSTD = 147456;
constexpr int LDS_BYTES = 155648;


struct Params { const float* in[30]; float* out; unsigned char* ws; int ph_lo, ph_hi; };
enum { I_X = 0, I_P, I_ATTN_NORM, I_W_IN, I_CONV_DN, I_CONV_ML, I_DN_A_LOG, I_DN_DT_BIAS, I_DN_NORM, I_LQ1, I_LK1, I_LQ2, I_LK2, I_DIFF_NORM, I_ML_I_BIAS, I_ML_F_BIAS, I_ML_NORM,
       I_W_OUT, I_FFN_NORM, I_DG, I_DU, I_DD, I_ROUTER, I_MG, I_MU, I_MD, I_PLE_NORM, I_PLE_PROJ, I_PLE_GATE, I_FINAL_NORM };
struct Frame { LAS unsigned char* lds; volatile LAS unsigned* MISC; int tid, lane, wave, G, bid; };

DI float wave_incl_sum(float v, int lane) {
#pragma unroll
    for (int o = 1; o < 64; o <<= 1) { const float t = __shfl_up(v, o); if (lane >= o) v += t; }
    return v;
}
DI float wave_incl_max(float v, int lane) {
#pragma unroll
    for (int o = 1; o < 64; o <<= 1) { const float t = __shfl_up(v, o); if (lane >= o) v = fmaxf(v, t); }
    return v;
}
DI bf16x8 frag_row(const LAS unsigned char* base, int RS, int r0, int k0, int lane) { return *(const LAS bf16x8*)(base + (r0 + (lane & 15)) * RS + (k0 + 8 * (lane >> 4)) * 2); }
DI bf16x8 frag_tr2(unsigned base_addr, int RS, int rowA, int rowB, int c0, int lane) {
    const int q = (lane & 15) >> 2, p = lane & 3;
    const unsigned a0 = base_addr + (unsigned)((rowA + q) * RS + (c0 + 4 * p) * 2), a1 = base_addr + (unsigned)((rowB + q) * RS + (c0 + 4 * p) * 2);
    s16x4 x, y;
    asm volatile("ds_read_b64_tr_b16 %0, %2\n\tds_read_b64_tr_b16 %1, %3\n\ts_waitcnt lgkmcnt(0)" : "=&v"(x), "=&v"(y) : "v"(a0), "v"(a1) : "memory");
    bf16x8 r; r[0] = x[0]; r[1] = x[1]; r[2] = x[2]; r[3] = x[3]; r[4] = y[0]; r[5] = y[1]; r[6] = y[2]; r[7] = y[3]; return r;
}
DI bf16x8 frag_tr(unsigned base_addr, int RS, int k0, int c0, int lane) { const int g = lane >> 4; return frag_tr2(base_addr, RS, k0 + 8 * g, k0 + 8 * g + 4, c0, lane); }
#define MFMA16(a, b, c) __builtin_amdgcn_mfma_f32_16x16x32_bf16((a), (b), (c), 0, 0, 0)

template <bool F8> DI void tr_tile(const float* __restrict__ W, int ldn, int K, int k0, int nsrc0, unsigned char* __restrict__ WT, int ndst0, LAS unsigned char* scr, int lane, float wscale, const float* gk = nullptr  ) {
    const int r = lane >> 4, c4 = lane & 15;
    f32x4 v[16];
#pragma unroll
    for (int i = 0; i < 16; ++i) v[i] = __builtin_nontemporal_load((const f32x4*)(W + (size_t)(k0 + 4 * i + r) * ldn + nsrc0 + 4 * c4));
#pragma unroll
    for (int i = 0; i < 16; ++i) { f32x4 x = F8 ? v[i] * wscale : v[i]; if (!F8 && gk) x = x * gk[k0 + 4 * i + r];
        *(LAS unsigned long long*)(scr + (4 * i + r) * 144 + c4 * 8) = (unsigned long long)pk2(x[0], x[1]) | ((unsigned long long)pk2(x[2], x[3]) << 32); }
    LDS_WAIT();
    const int g = lane >> 4, j = lane & 15, q = j >> 2, pp = j & 3;
    if constexpr (F8) {
        const unsigned base = (unsigned)(size_t)scr + (unsigned)((16 * g + q) * 144 + pp * 8);
#pragma unroll
        for (int nb = 0; nb < 4; ++nb) {
            s16x4 l0, h0, l1, h1; const unsigned a0 = base + (unsigned)(32 * nb);
            asm volatile("ds_read_b64_tr_b16 %0, %4\n\tds_read_b64_tr_b16 %1, %4 offset:576\n\tds_read_b64_tr_b16 %2, %4 offset:1152\n\tds_read_b64_tr_b16 %3, %4 offset:1728\n\ts_waitcnt lgkmcnt(0)" : "=&v"(l0), "=&v"(h0), "=&v"(l1), "=&v"(h1) : "v"(a0) : "memory");
            const size_t n = (size_t)(ndst0 + 16 * nb + j); const int kk = k0 + 16 * g;
            u32x4 o; o.x = pk4_fp8(bf2f((bf16)l0[0]), bf2f((bf16)l0[1]), bf2f((bf16)l0[2]), bf2f((bf16)l0[3])); o.y = pk4_fp8(bf2f((bf16)h0[0]), bf2f((bf16)h0[1]), bf2f((bf16)h0[2]), bf2f((bf16)h0[3]));
            o.z = pk4_fp8(bf2f((bf16)l1[0]), bf2f((bf16)l1[1]), bf2f((bf16)l1[2]), bf2f((bf16)l1[3])); o.w = pk4_fp8(bf2f((bf16)h1[0]), bf2f((bf16)h1[1]), bf2f((bf16)h1[2]), bf2f((bf16)h1[3]));
            *(u32x4*)(WT + n * K + kk) = o; }
    } else {
        const unsigned base = (unsigned)(size_t)scr + (unsigned)((8 * g + q) * 144 + pp * 8);
#pragma unroll
        for (int nb = 0; nb < 4; ++nb)
#pragma unroll
            for (int kh = 0; kh < 2; ++kh) {
                s16x4 lo, hi; const unsigned a0 = base + (unsigned)(32 * kh * 144 + 32 * nb);
                asm volatile("ds_read_b64_tr_b16 %0, %2\n\tds_read_b64_tr_b16 %1, %2 offset:576\n\ts_waitcnt lgkmcnt(0)" : "=&v"(lo), "=&v"(hi) : "v"(a0) : "memory");
                const size_t n = (size_t)(ndst0 + 16 * nb + j); const int kk = k0 + 32 * kh + 8 * g;
                bf16x8 o; o[0] = lo[0]; o[1] = lo[1]; o[2] = lo[2]; o[3] = lo[3]; o[4] = hi[0]; o[5] = hi[1]; o[6] = hi[2]; o[7] = hi[3];
                *(bf16x8*)(WT + (n * K + kk) * 2) = o; } }
    LDS_WAIT();
}
template <int PART> DI void prologue_phase(const Params& P, const Frame& F) {
    LAS unsigned char* scr = F.lds + F.wave * 9216;
    const int gw = (PART == 0 ? F.bid : F.bid - (GRID - NCONV)) * NWAVES + F.wave, NGW = (PART == 0 ? GRID : NCONV) * NWAVES;
    constexpr int I_WIN = 32 * 112, I_WOUT = 32 * 32, I_GU = 32 * 224, I_DN = 112 * 32, I_PG = 32 * 32, I_PP = 4 * 32;
    constexpr int C0 = 2 * I_WIN, C1 = C0 + 2 * I_WOUT, C2 = C1 + I_GU, C3 = C2 + I_DN, C4 = C3 + 8 * I_GU, C5 = C4 + 8 * I_DN, C6 = C5 + 2 * I_PG, C7 = C6 + 2 * I_PP;
    unsigned char* ws = P.ws;
    for (int it = (PART == 0 ? 0 : I_WIN) + gw; it < (PART == 0 ? I_WIN : C7); it += NGW) {
        const float* src; const float* src2 = nullptr; bf16* dst; int K, ldn, ntn, r, kind = 0; const bool f8 = (it >= C2 && it < C5) || (it >= C5 + I_PG && it < C6);
        if (it < C0)      { const int l = it / I_WIN; r = it % I_WIN; src = P.in[I_W_IN] + (size_t)l * D * NIN; dst = (bf16*)(ws + WS_WIN) + (size_t)l * NZ * D; K = D; ldn = NIN; ntn = NZ / 64; kind = 1; }
        else if (it < C1) { const int q = it - C0, l = q / I_WOUT; r = q % I_WOUT; src = P.in[I_W_OUT] + (size_t)l * D * D; dst = (bf16*)(ws + WS_WOUT) + (size_t)l * D * D; K = D; ldn = D; ntn = D / 64; }
        else if (it < C2) { r = it - C1; src = P.in[I_DG]; src2 = P.in[I_DU]; dst = (bf16*)(ws + WS_WGU); K = D; ldn = DFF; ntn = 2 * DFF / 64; kind = 2; }
        else if (it < C3) { r = it - C2; src = P.in[I_DD]; dst = (bf16*)(ws + WS_WD); K = DFF; ldn = D; ntn = D / 64; }
        else if (it < C4) { const int q = it - C3, e = q / I_GU; r = q % I_GU; src = P.in[I_MG] + (size_t)e * D * DFF; src2 = P.in[I_MU] + (size_t)e * D * DFF; dst = (bf16*)(ws + WS_MGU + (size_t)e * 2 * DFF * D); K = D; ldn = DFF; ntn = 2 * DFF / 64; kind = 2; }
        else if (it < C5) { const int q = it - C4, e = q / I_DN; r = q % I_DN; src = P.in[I_MD] + (size_t)e * DFF * D; dst = (bf16*)(ws + WS_MD + (size_t)e * D * DFF); K = DFF; ldn = D; ntn = D / 64; }
        else if (it < C6) { const int q = it - C5, l = q / I_PG; r = q % I_PG; src = P.in[I_PLE_GATE] + (size_t)l * D * D; dst = (bf16*)(ws + WS_WPG) + (size_t)l * D * D; K = D; ldn = D; ntn = D / 64; }
        else              { const int q = it - C6, l = q / I_PP; r = q % I_PP; src = P.in[I_PLE_PROJ] + (size_t)l * PLE * D; dst = (bf16*)(ws + WS_WPP) + (size_t)l * D * PLE; K = PLE; ldn = D; ntn = D / 64; }
        const int kb = r / ntn, nb = r % ntn, k0 = 64 * kb, ndst0 = 64 * nb;
        int nsrc0 = ndst0;
        if (kind == 1) nsrc0 = ndst0 + (ndst0 >= 3072 ? 8 : 0);
        if (kind == 2) { const int t = nb >> 2, q = nb & 3; if (q >= 2) src = src2; nsrc0 = 128 * t + 64 * (q & 1); }
        if (f8) tr_tile<true>(src, ldn, K, k0, nsrc0, (unsigned char*)dst, ndst0, scr, F.lane, (kind == 2 || it >= C5) ? (float)(1 << LS_WGU) : (float)(1 << LS_WD));
        else tr_tile<false>(src, ldn, K, k0, nsrc0, (unsigned char*)dst, ndst0, scr, F.lane, 1.0f, (it >= C1 && it < C2) ? P.in[I_FFN_NORM] : (it >= C5 && it < C5 + I_PG) ? P.in[I_PLE_NORM] : nullptr);
    }
    if (PART == 1) {
        const f32x4* src = (const f32x4*)P.in[I_P]; unsigned long long* dst = (unsigned long long*)(ws + WS_T + T_PB0);
        for (int i = gw * 64 + F.lane; i < M * PLE / 4; i += NGW * 64) { const f32x4 pv = __builtin_nontemporal_load(src + i); dst[i] = (unsigned long long)pk2(pv[0], pv[1]) | ((unsigned long long)pk2(pv[2], pv[3]) << 32); }
        return; }
    const int gt = F.bid * NTHR + F.tid, NGT = F.G * NTHR;
    float* WGT = (float*)(ws + WS_WGT); float* WRT = (float*)(ws + WS_WRT);
    for (int e = gt; e < 2 * 16 * D; e += NGT) { const int l = e / (16 * D), j = (e / D) % 16, k = e % D; const int col = j < 8 ? 3072 + j : 7176 + (j - 8);
        WGT[e] = P.in[I_W_IN][((size_t)l * D + k) * NIN + col]; }
    for (int e = gt; e < NEXP * D; e += NGT) { const int j = e / D, k = e % D; WRT[e] = P.in[I_ROUTER][(size_t)k * NEXP + j]; }
}

DI void rstd_fill(const Params& P, const Frame& F) {
    const float* SS = (const float*)(P.ws + WS_T + T_SS); LAS float* rs = (LAS float*)(F.lds + LDS_RSTD); const int base = 2048 * (F.bid & 7);
    for (int i = F.tid; i < 2048; i += NTHR) { const f32x4 a = *(const f32x4*)(SS + (size_t)(base + i) * 8), b = *(const f32x4*)(SS + (size_t)(base + i) * 8 + 4);
        rs[i] = 1.0f / sqrtf((((a[0] + a[1]) + (a[2] + a[3])) + ((b[0] + b[1]) + (b[2] + b[3]))) * (1.0f / D) + EPS); }
    __syncthreads();
}
template <int MODE, bool SB  > DI void norm_phase(const Params& P, const Frame& F, int L, const void* src_, const float* gain, bool combine) {
    const float* src = (const float*)src_; const bf16* srcb = (const bf16*)src_;
    unsigned char* ws = P.ws;
    const int r_lo = (int)((long)F.bid * M / F.G), r_hi = (int)((long)(F.bid + 1) * M / F.G);
    bf16* HN = (bf16*)(ws + WS_HN);
    if (MODE == 1) { const f32x4* w = (const f32x4*)((const float*)(ws + WS_WGT) + (size_t)L * 16 * D); for (int i = F.tid; i < 16 * D / 4; i += NTHR) ((LAS f32x4*)F.lds)[i] = w[i]; __syncthreads(); }
    if (MODE == 2) { const f32x4* w = (const f32x4*)(ws + WS_WRT); for (int i = F.tid; i < NEXP * D / 4; i += NTHR) ((LAS f32x4*)F.lds)[i] = w[i]; if (F.tid < 8) F.MISC[16 + F.tid] = 0u; __syncthreads(); }
    f32x4 g[8];
#pragma unroll
    for (int j = 0; j < 8; ++j) g[j] = *(const f32x4*)(gain + 4 * F.lane + 256 * j);
    f32x4 vn[SB ? 1 : 8]; u32x2 vb[SB ? 8 : 1];
#pragma unroll
    for (int j = 0; j < 8; ++j) { if constexpr (SB) vb[j] = *(const u32x2*)(srcb + (size_t)(r_lo + F.wave) * D + 4 * F.lane + 256 * j); else vn[j] = *(const f32x4*)(src + (size_t)(r_lo + F.wave) * D + 4 * F.lane + 256 * j); }
#pragma unroll 1
    for (int row = r_lo + F.wave; row < r_hi; row += NWAVES) {
        f32x4 v[8];
#pragma unroll
        for (int j = 0; j < 8; ++j) { if constexpr (SB) v[j] = (f32x4){bflo(vb[j].x), bfhi(vb[j].x), bflo(vb[j].y), bfhi(vb[j].y)}; else v[j] = vn[j]; }
        { const int rnx = (row + NWAVES < r_hi) ? row + NWAVES : row;
#pragma unroll
          for (int j = 0; j < 8; ++j) { if constexpr (SB) vb[j] = *(const u32x2*)(srcb + (size_t)rnx * D + 4 * F.lane + 256 * j); else vn[j] = *(const f32x4*)(src + (size_t)rnx * D + 4 * F.lane + 256 * j); } }
        if (MODE == 3 && combine) {
            const int* SLOT = (const int*)(ws + WS_SLOT); const float* TOPW = (const float*)(ws + WS_TOPW); const bf16* Y = (const bf16*)(ws + WS_T + T_YPERM);
            const int s1 = SLOT[row * 2], s2 = SLOT[row * 2 + 1]; const float w1 = TOPW[row * 2], w2 = TOPW[row * 2 + 1];
            u32x2 ya[8], yb[8];
#pragma unroll
            for (int j = 0; j < 8; ++j) { ya[j] = *(const u32x2*)(Y + (size_t)s1 * D + 4 * F.lane + 256 * j); yb[j] = *(const u32x2*)(Y + (size_t)s2 * D + 4 * F.lane + 256 * j); }
#pragma unroll
            for (int j = 0; j < 8; ++j) { const f32x4 y1 = (f32x4){bflo(ya[j].x), bfhi(ya[j].x), bflo(ya[j].y), bfhi(ya[j].y)}, y2 = (f32x4){bflo(yb[j].x), bfhi(yb[j].x), bflo(yb[j].y), bfhi(yb[j].y)};
                v[j] = v[j] + w1 * y1 + w2 * y2;
                const u32x2 hb = {pk2(v[j][0], v[j][1]), pk2(v[j][2], v[j][3])}; *(u32x2*)(const_cast<bf16*>(srcb) + (size_t)row * D + 4 * F.lane + 256 * j) = hb;
                v[j] = (f32x4){bflo(hb.x), bfhi(hb.x), bflo(hb.y), bfhi(hb.y)}; }
        }
        float ss = 0.f;
#pragma unroll
        for (int j = 0; j < 8; ++j) ss += (v[j][0] * v[j][0] + v[j][1] * v[j][1]) + (v[j][2] * v[j][2] + v[j][3] * v[j][3]);
        const float rstd = 1.0f / sqrtf(wave_sum(ss) * (1.0f / D) + EPS);
#pragma unroll
        for (int j = 0; j < 8; ++j) v[j] = v[j] * rstd * g[j];
        if (MODE == 4) {
#pragma unroll
            for (int j = 0; j < 8; ++j) *(f32x4*)(P.out + (size_t)row * D + 4 * F.lane + 256 * j) = v[j];
        } else if (MODE == 2 || (MODE == 3 && L == 1)) {
            unsigned* o4 = (unsigned*)((unsigned char*)HN + (size_t)row * D) + F.lane; const float hs = (float)(1 << LS_HN);
#pragma unroll
            for (int j = 0; j < 8; ++j) o4[64 * j] = pk4_fp8(v[j][0] * hs, v[j][1] * hs, v[j][2] * hs, v[j][3] * hs);
        } else {
            unsigned long long* o8 = (unsigned long long*)(HN + (size_t)row * D) + F.lane;
#pragma unroll
            for (int j = 0; j < 8; ++j) o8[64 * j] = (unsigned long long)pk2(v[j][0], v[j][1]) | ((unsigned long long)pk2(v[j][2], v[j][3]) << 32);
        }
        if (MODE == 1) {
            float s[16];
#pragma unroll
            for (int q = 0; q < 16; ++q) { float t = 0.f;
#pragma unroll
                for (int j = 0; j < 8; ++j) { const f32x4 w = *(const LAS f32x4*)(F.lds + (size_t)(q * D + 256 * j + 4 * F.lane) * 4); t += (v[j][0] * w[0] + v[j][1] * w[1]) + (v[j][2] * w[2] + v[j][3] * w[3]); }
                s[q] = t; if ((q & 3) == 3) asm volatile("" ::: "memory"); }
#pragma unroll
            for (int i = 0; i < 8; ++i) { const bool hi = (F.lane & 32) != 0; const float send = hi ? s[i] : s[i + 8], keep = hi ? s[i + 8] : s[i]; s[i] = keep + shx<32>(send); }
#pragma unroll
            for (int i = 0; i < 4; ++i) { const bool hi = (F.lane & 16) != 0; const float send = hi ? s[i] : s[i + 4], keep = hi ? s[i + 4] : s[i]; s[i] = keep + shx<16>(send); }
#pragma unroll
            for (int i = 0; i < 2; ++i) { const bool hi = (F.lane & 8) != 0; const float send = hi ? s[i] : s[i + 2], keep = hi ? s[i + 2] : s[i]; s[i] = keep + shx<8>(send); }
            { const bool hi = (F.lane & 4) != 0; const float send = hi ? s[0] : s[1], keep = hi ? s[1] : s[0]; s[0] = keep + shx<4>(send); }
            float mine = s[0]; mine += shx<2>(mine); mine += shx<1>(mine);
            if ((F.lane & 3) == 0) { const int gi = ((F.lane >> 5) & 1) * 8 + ((F.lane >> 4) & 1) * 4 + ((F.lane >> 3) & 1) * 2 + ((F.lane >> 2) & 1), h = gi & 3; float r;
                if (gi < 4) r = sigmoidf_(mine);
                else if (gi < 8) r = -__expf(P.in[I_DN_A_LOG][L * 4 + h]) * softplusf_(mine + P.in[I_DN_DT_BIAS][L * 4 + h]);
                else if (gi < 12) r = mine + P.in[I_ML_I_BIAS][L * 4 + h];
                else r = -softplusf_(-(mine + P.in[I_ML_F_BIAS][L * 4 + h]));
                ((float*)(ws + WS_GD))[(size_t)row * 16 + gi] = r; }
        }
        if (MODE == 2) {
            int e1 = 0, e2 = 0; float l1 = -INFINITY, l2 = -INFINITY;
#pragma unroll 1
            for (int q = 0; q < 8; ++q) { float s = 0.f;
#pragma unroll
                for (int j = 0; j < 8; ++j) { const f32x4 w = *(const LAS f32x4*)(F.lds + (size_t)(q * D + 256 * j + 4 * F.lane) * 4); s += (v[j][0] * w[0] + v[j][1] * w[1]) + (v[j][2] * w[2] + v[j][3] * w[3]); }
                s = wave_sum(s);
                if (s > l1) { l2 = l1; e2 = e1; l1 = s; e1 = q; } else if (s > l2) { l2 = s; e2 = q; } }
            if (F.lane == 0) { const float w1 = 1.0f / (1.0f + __expf(l2 - l1));
                ((int*)(ws + WS_TOPE))[row * 2] = e1; ((int*)(ws + WS_TOPE))[row * 2 + 1] = e2; ((float*)(ws + WS_TOPW))[row * 2] = w1; ((float*)(ws + WS_TOPW))[row * 2 + 1] = 1.0f - w1;
                __hip_atomic_fetch_add((LAS unsigned*)&F.MISC[16 + e1], 1u, __ATOMIC_RELAXED, __HIP_MEMORY_SCOPE_WORKGROUP);
                __hip_atomic_fetch_add((LAS unsigned*)&F.MISC[16 + e2], 1u, __ATOMIC_RELAXED, __HIP_MEMORY_SCOPE_WORKGROUP); }
        }
        if (MODE == 3) { const f32x4 pv = *(const f32x4*)(P.in[I_P] + ((size_t)L * M + row) * PLE + 4 * F.lane);
            *((unsigned long long*)((bf16*)(ws + WS_T + T_PB) + (size_t)row * PLE) + F.lane) = (unsigned long long)pk2(pv[0], pv[1]) | ((unsigned long long)pk2(pv[2], pv[3]) << 32); }
    }
    if (MODE == 2) { __syncthreads(); if (F.tid < 8) ((int*)(ws + WS_BLKCNT))[F.bid * 8 + F.tid] = (int)F.MISC[16 + F.tid]; }
    if (MODE == 1 || MODE == 2) __syncthreads();
}

DI void moe_gather_phase(const Params& P, const Frame& F) {
    unsigned char* ws = P.ws;
    const int r_lo = (int)((long)F.bid * M / F.G), r_hi = (int)((long)(F.bid + 1) * M / F.G), nr = r_hi - r_lo;
    LAS int* tot = (LAS int*)F.lds; LAS int* pre = tot + 8; LAS int* base = tot + 16; LAS int* tope = tot + 64; LAS int* slots = tot + 64 + 1024;
    const int* BLK = (const int*)(ws + WS_BLKCNT); const int* TOPE = (const int*)(ws + WS_TOPE);
    if (F.tid < 16) tot[F.tid] = 0;
    __syncthreads();
    for (int i = F.tid; i < F.G * 8; i += NTHR) { const int v = BLK[i], c = i >> 3, e = i & 7;
        __hip_atomic_fetch_add(&tot[e], v, __ATOMIC_RELAXED, __HIP_MEMORY_SCOPE_WORKGROUP); if (c < F.bid) __hip_atomic_fetch_add(&pre[e], v, __ATOMIC_RELAXED, __HIP_MEMORY_SCOPE_WORKGROUP); }
    for (int i = F.tid; i < 2 * nr; i += NTHR) tope[i] = TOPE[r_lo * 2 + i];
    __syncthreads();
    if (F.tid == 0) {
        int off = 0; int* TILE_E = (int*)(ws + WS_TILEE);
        for (int e = 0; e < 8; ++e) { const int pad = (tot[e] + 255) & ~255; base[e] = off + pre[e];
            if (F.bid == 0) for (int t = off / 256; t < (off + pad) / 256; ++t) TILE_E[t] = e;
            off += pad; }
        if (F.bid == 0) TILE_E[255] = off / 256;
        int* SLOT = (int*)(ws + WS_SLOT);
        for (int i = 0; i < 2 * nr; ++i) { const int e = tope[i]; const int s = base[e]; base[e] = s + 1; slots[i] = s; SLOT[r_lo * 2 + i] = s; }
    }
    __syncthreads();
    const unsigned char* HN = (const unsigned char*)(ws + WS_HN); unsigned char* AP = (unsigned char*)(ws + WS_T + T_APERM);
    for (int i = F.tid >> 7; i < 2 * nr; i += 4) { const int row = r_lo + (i >> 1), s = slots[i];
        ((u32x4*)(AP + (size_t)s * D))[F.tid & 127] = ((const u32x4*)(HN + (size_t)row * D))[F.tid & 127]; }
    __syncthreads();
}

DI void prep_phase(const Params& P, const Frame& F, int L) {
    unsigned char* ws = P.ws;
    LAS float* CW = (LAS float*)F.lds;
    for (int i = F.tid; i < 4 * 2560; i += NTHR) { const int tap = i / 2560, ch = i % 2560;
        CW[i] = ch < 1536 ? P.in[I_CONV_DN][(size_t)(L * 4 + tap) * 1536 + ch] : P.in[I_CONV_ML][(size_t)(L * 4 + tap) * 1024 + ch - 1536]; }
    __syncthreads();
    const int gw = F.bid * NWAVES + F.wave, NGW = F.G * NWAVES;
    const float* GD = (const float*)(ws + WS_GD);
    if (gw < 32) {
        const int b = gw >> 2, h = gw & 3; float m_st = 0.f; float* MLS = (float*)(ws + WS_MLS); float* MLCS = (float*)(ws + WS_MLCS);
        float lfa[32], ipa[32];
#pragma unroll
        for (int n = 0; n < 32; ++n) { const size_t row = (size_t)b * SEQ + 64 * n + F.lane; lfa[n] = GD[row * 16 + 12 + h]; ipa[n] = GD[row * 16 + 8 + h]; }
        float pma[32], bla[32], pxa[32];
#pragma unroll
        for (int n = 0; n < 32; ++n) { const float bc = wave_incl_sum(lfa[n], F.lane); bla[n] = __shfl(bc, 63); const float e = ipa[n] - bc; const float pm = wave_incl_max(e, F.lane); pxa[n] = __shfl(pm, 63);
            lfa[n] = bc; ipa[n] = e; pma[n] = pm; }
#pragma unroll
        for (int n = 0; n < 32; ++n) {
            const size_t row = (size_t)b * SEQ + 64 * n + F.lane;
            const float bc = lfa[n], e = ipa[n], blast = bla[n], pmax = pxa[n];
            const float mt = fmaxf(bc + pma[n], bc + m_st), m_new = fmaxf(blast + m_st, blast + pmax);
            *(f32x4*)(MLS + (row * 4 + h) * 8) = (f32x4){e, bc - mt, __expf(bc + m_st - mt), __expf(-mt)};
            if (F.lane == 0) { MLCS[(b * 4 + h) * 32 + n] = __expf(blast + m_st - m_new); MLCS[NCHUNK + (b * 4 + h) * 32 + n] = __expf(blast + pmax - m_new); }
            m_st = m_new;
        }
    }
    const bf16* Z = (const bf16*)(ws + WS_T + T_Z); bf16* ZC = (bf16*)(ws + WS_T + T_ZC);
    {
        static_assert(M / (GRID * NWAVES) == 8, "prep: 8 rows per wave");
        const int rbeg = gw * 8; const bool hist = (rbeg % SEQ) != 0;
        const __amdgpu_buffer_rsrc_t rz = __builtin_amdgcn_make_buffer_rsrc((void*)Z, 0, 0xFFFFFFFF, 0x00020000), rc = __builtin_amdgcn_make_buffer_rsrc((void*)ZC, 0, 0xFFFFFFFF, 0x00020000);
#pragma unroll 1
        for (int i = 0; i < 5; ++i) {
            const int vo = F.lane * 16 + 1024 * i;
            u32x4 rows[11];
#pragma unroll
            for (int k = 0; k < 11; ++k) rows[k] = (k >= 3 || hist) ? *(const u32x4*)((const unsigned char*)Z + (size_t)(rbeg - 3 + k) * (NZ * 2) + vo) : (u32x4){0u, 0u, 0u, 0u};
            f32x4 w[4][2];
#pragma unroll
            for (int tap = 0; tap < 4; ++tap) { const LAS unsigned char* wp = (const LAS unsigned char*)CW + F.lane * 32 + (tap * 2560 + 512 * i) * 4; w[tap][0] = *(const LAS f32x4*)wp; w[tap][1] = *(const LAS f32x4*)(wp + 16); }
            const float qs = (i == 0 || i == 4) ? 0.08838834764831845f : 1.0f; const bool nrm = i < 2;
#pragma unroll
            for (int r = 0; r < 8; ++r) {
                float a[8];
#pragma unroll
                for (int e = 0; e < 8; ++e) a[e] = 0.f;
#pragma unroll
                for (int tap = 0; tap < 4; ++tap) { const u32x4 x = rows[r + tap];
                    a[0] += bflo(x.x) * w[tap][0][0]; a[1] += bfhi(x.x) * w[tap][0][1]; a[2] += bflo(x.y) * w[tap][0][2]; a[3] += bfhi(x.y) * w[tap][0][3];
                    a[4] += bflo(x.z) * w[tap][1][0]; a[5] += bfhi(x.z) * w[tap][1][1]; a[6] += bflo(x.w) * w[tap][1][2]; a[7] += bfhi(x.w) * w[tap][1][3]; }
                float ss = 0.f;
#pragma unroll
                for (int e = 0; e < 8; ++e) { a[e] = siluf_(a[e]); ss += a[e] * a[e]; }
                ss += shx<1>(ss); ss += shx<2>(ss); ss += shx<4>(ss); ss += shx<8>(ss);
                const float sc = (nrm ? __builtin_amdgcn_rsqf(ss + EPS) : 1.0f) * qs;
                u32x4 o; o.x = pk2(a[0] * sc, a[1] * sc); o.y = pk2(a[2] * sc, a[3] * sc); o.z = pk2(a[4] * sc, a[5] * sc); o.w = pk2(a[6] * sc, a[7] * sc);
                *(u32x4*)((unsigned char*)ZC + (size_t)(rbeg + r) * (2560 * 2) + vo) = o;
            }
        }
    }
    __syncthreads();
}

constexpr int ATT_STAGE = 35840, ATT_KMAP = 9216, ATT_VOFF = 18432, ATT_KRS = 144, ATT_VRS = 272;
DI void attn_block(const Params& P, const Frame& F, int L, int b, int h, int qb, float lam, float oml) {
    unsigned char* ws = P.ws;
    const bf16* Z = (const bf16*)(ws + WS_T + T_Z); bf16* MIX = (bf16*)(ws + WS_T + T_MIX);
    const int lane = F.lane, c = lane & 15, rq = lane >> 4, wave = F.wave;
    const int q0 = qb * 128, qrow = q0 + 16 * wave + c;
    const size_t rowbase = (size_t)b * SEQ;
    bf16x8 qf[2][2];
#pragma unroll
    for (int j = 0; j < 2; ++j)
#pragma unroll
        for (int ks = 0; ks < 2; ++ks) qf[j][ks] = *(const bf16x8*)(Z + (rowbase + qrow) * NZ + 3072 + h * 128 + j * 64 + 32 * ks + 8 * rq);
    const float LOG2E = 1.4426950408889634f;
    const float sc = 0.125f * LOG2E, sl = __builtin_bit_cast(float, __builtin_amdgcn_readfirstlane(__builtin_bit_cast(int, exp2f(-(float)(h + 1)) * LOG2E)));
#pragma unroll
    for (int j = 0; j < 2; ++j)
#pragma unroll
        for (int ks = 0; ks < 2; ++ks) { const u32x4 qv = __builtin_bit_cast(u32x4, qf[j][ks]); u32x4 o;
            o.x = pk2(bflo(qv.x) * sc, bfhi(qv.x) * sc); o.y = pk2(bflo(qv.y) * sc, bfhi(qv.y) * sc); o.z = pk2(bflo(qv.z) * sc, bfhi(qv.z) * sc); o.w = pk2(bflo(qv.w) * sc, bfhi(qv.w) * sc);
            qf[j][ks] = __builtin_bit_cast(bf16x8, o); }
    float sbias[16];
#pragma unroll
    for (int i = 0; i < 16; ++i) sbias[i] = __builtin_bit_cast(float, __builtin_amdgcn_readfirstlane(__builtin_bit_cast(int, sl * (float)(16 * (i >> 2) + (i & 3)))));
    f32x4 O[2][8];
#pragma unroll
    for (int j = 0; j < 2; ++j)
#pragma unroll
        for (int d = 0; d < 8; ++d) O[j][d] = (f32x4){0.f, 0.f, 0.f, 0.f};
    float mrun[2] = {-INFINITY, -INFINITY}, lrun[2] = {0.f, 0.f};
    const int nkt = 2 * (qb + 1);
    u32x4 st[4];
#define ATT_LOAD(kt_) do { const int k0_ = 64 * (kt_); _Pragma("unroll") for (int i_ = 0; i_ < 2; ++i_) { const int id_ = F.tid + 512 * i_, key_ = id_ >> 4, ch_ = id_ & 15; \
        st[i_] = *(const u32x4*)(Z + (rowbase + k0_ + key_) * NZ + 4096 + h * 128 + ch_ * 8); st[2 + i_] = *(const u32x4*)(Z + (rowbase + k0_ + key_) * NZ + 5120 + h * 128 + ch_ * 8); } } while (0)
#define ATT_STORE(s_) do { LAS unsigned char* sb_ = F.lds + (s_) * ATT_STAGE; _Pragma("unroll") for (int i_ = 0; i_ < 2; ++i_) { const int id_ = F.tid + 512 * i_, key_ = id_ >> 4, ch_ = id_ & 15; \
        *(LAS u32x4*)(sb_ + (ch_ >> 3) * ATT_KMAP + key_ * ATT_KRS + (ch_ & 7) * 16) = st[i_]; *(LAS u32x4*)(sb_ + ATT_VOFF + key_ * ATT_VRS + ch_ * 16) = st[2 + i_]; } } while (0)
    ATT_LOAD(nkt - 1); ATT_STORE(0); __syncthreads();
#pragma unroll 1
    for (int kk = 0; kk < nkt; ++kk) {
        const int kt = nkt - 1 - kk;
        if (kk + 1 < nkt) ATT_LOAD(kt - 1);
        const int k0 = 64 * kt;
        if (k0 <= q0 + 16 * wave + 15) {
            const LAS unsigned char* Kb = F.lds + (kk & 1) * ATT_STAGE;
            const unsigned Va = (unsigned)(size_t)(F.lds + (kk & 1) * ATT_STAGE + ATT_VOFF);
            const bool diag = (k0 + 63 > q0 + 16 * wave);
            const int lim = qrow - k0 - 4 * rq;
            const float base2 = sl * (float)(k0 + 4 * rq - qrow);
            bf16x8 pf[2][2];
#pragma unroll
            for (int j = 0; j < 2; ++j) {
                f32x2 x2[8]; float mx = -INFINITY;
#pragma unroll
                for (int nt = 0; nt < 4; ++nt) {
                    f32x4 a = (f32x4){0.f, 0.f, 0.f, 0.f};
#pragma unroll
                    for (int ks = 0; ks < 2; ++ks) a = MFMA16(frag_row(Kb + j * ATT_KMAP, ATT_KRS, 16 * nt, 32 * ks, lane), qf[j][ks], a);
                    x2[2 * nt] = (f32x2){a[0], a[1]} + (f32x2){sbias[4 * nt], sbias[4 * nt + 1]}; x2[2 * nt + 1] = (f32x2){a[2], a[3]} + (f32x2){sbias[4 * nt + 2], sbias[4 * nt + 3]};
                }
                if (diag) {
#pragma unroll
                    for (int i = 0; i < 8; ++i) { x2[i].x = (16 * (i >> 1) + 2 * (i & 1) <= lim) ? x2[i].x : -INFINITY; x2[i].y = (16 * (i >> 1) + 2 * (i & 1) + 1 <= lim) ? x2[i].y : -INFINITY; } }
#pragma unroll
                for (int i = 0; i < 8; ++i) { mx = fmaxf(mx, x2[i].x); mx = fmaxf(mx, x2[i].y); }
                mx += base2;
                mx = fmaxf(mx, shx<16>(mx)); mx = fmaxf(mx, shx<32>(mx));
                const float mnew = fmaxf(mrun[j], mx), alpha = __builtin_amdgcn_exp2f(mrun[j] - mnew), msub = mnew - base2;
                const f32x2 ms2 = (f32x2){msub, msub}; f32x2 ps2 = (f32x2){0.f, 0.f};
#pragma unroll
                for (int i = 0; i < 8; ++i) { const f32x2 t = x2[i] - ms2; x2[i] = (f32x2){__builtin_amdgcn_exp2f(t.x), __builtin_amdgcn_exp2f(t.y)}; ps2 = ps2 + x2[i]; }
                lrun[j] = lrun[j] * alpha + (ps2.x + ps2.y); mrun[j] = mnew;
                if (__builtin_amdgcn_ballot_w64(alpha != 1.0f) != 0ull) {
#pragma unroll
                    for (int d = 0; d < 8; ++d) O[j][d] = O[j][d] * alpha; }
#pragma unroll
                for (int k2 = 0; k2 < 2; ++k2) { u32x4 w; w.x = pk2(x2[4 * k2].x, x2[4 * k2].y); w.y = pk2(x2[4 * k2 + 1].x, x2[4 * k2 + 1].y); w.z = pk2(x2[4 * k2 + 2].x, x2[4 * k2 + 2].y); w.w = pk2(x2[4 * k2 + 3].x, x2[4 * k2 + 3].y);
                    pf[j][k2] = __builtin_bit_cast(bf16x8, w); }
            }
            {
                const int tq = (lane & 15) >> 2, tp = lane & 3;
                const unsigned ab = Va + (unsigned)((4 * rq + tq) * ATT_VRS + 8 * tp);
                s16x4 va[8], vb[8], vc[8], vd[8];
#define ATT_TR8(dst, addr) asm volatile("ds_read_b64_tr_b16 %0, %8\n\tds_read_b64_tr_b16 %1, %8 offset:32\n\tds_read_b64_tr_b16 %2, %8 offset:64\n\tds_read_b64_tr_b16 %3, %8 offset:96\n\t" \
                    "ds_read_b64_tr_b16 %4, %8 offset:128\n\tds_read_b64_tr_b16 %5, %8 offset:160\n\tds_read_b64_tr_b16 %6, %8 offset:192\n\tds_read_b64_tr_b16 %7, %8 offset:224" \
                    : "=&v"(dst[0]), "=&v"(dst[1]), "=&v"(dst[2]), "=&v"(dst[3]), "=&v"(dst[4]), "=&v"(dst[5]), "=&v"(dst[6]), "=&v"(dst[7]) : "v"(addr) : "memory")
                ATT_TR8(va, ab); ATT_TR8(vb, ab + 16 * ATT_VRS);
                asm volatile("s_waitcnt lgkmcnt(0)" : "+v"(va[0]), "+v"(va[1]), "+v"(va[2]), "+v"(va[3]), "+v"(va[4]), "+v"(va[5]), "+v"(va[6]), "+v"(va[7]), "+v"(vb[0]), "+v"(vb[1]), "+v"(vb[2]), "+v"(vb[3]), "+v"(vb[4]), "+v"(vb[5]), "+v"(vb[6]), "+v"(vb[7]) :: "memory");
#pragma unroll
                for (int d = 0; d < 8; ++d) { bf16x8 vf; vf[0] = va[d][0]; vf[1] = va[d][1]; vf[2] = va[d][2]; vf[3] = va[d][3]; vf[4] = vb[d][0]; vf[5] = vb[d][1]; vf[6] = vb[d][2]; vf[7] = vb[d][3];
                    O[0][d] = MFMA16(vf, pf[0][0], O[0][d]); O[1][d] = MFMA16(vf, pf[1][0], O[1][d]); }
                ATT_TR8(vc, ab + 32 * ATT_VRS); ATT_TR8(vd, ab + 48 * ATT_VRS);
                asm volatile("s_waitcnt lgkmcnt(0)" : "+v"(vc[0]), "+v"(vc[1]), "+v"(vc[2]), "+v"(vc[3]), "+v"(vc[4]), "+v"(vc[5]), "+v"(vc[6]), "+v"(vc[7]), "+v"(vd[0]), "+v"(vd[1]), "+v"(vd[2]), "+v"(vd[3]), "+v"(vd[4]), "+v"(vd[5]), "+v"(vd[6]), "+v"(vd[7]) :: "memory");
#pragma unroll
                for (int d = 0; d < 8; ++d) { bf16x8 vf; vf[0] = vc[d][0]; vf[1] = vc[d][1]; vf[2] = vc[d][2]; vf[3] = vc[d][3]; vf[4] = vd[d][0]; vf[5] = vd[d][1]; vf[6] = vd[d][2]; vf[7] = vd[d][3];
                    O[0][d] = MFMA16(vf, pf[0][1], O[0][d]); O[1][d] = MFMA16(vf, pf[1][1], O[1][d]); }
#undef ATT_TR8
            }
        }
        if (kk + 1 < nkt) ATT_STORE((kk + 1) & 1);
        __syncthreads();
    }
#undef ATT_LOAD
#undef ATT_STORE
    const float* nw = P.in[I_DIFF_NORM] + L * 128;
    f32x4 nwv[8];
#pragma unroll
    for (int d = 0; d < 8; ++d) nwv[d] = *(const f32x4*)(nw + 16 * d + 4 * rq);
    float inv[2];
#pragma unroll
    for (int j = 0; j < 2; ++j) { float l = lrun[j]; l += shx<16>(l); l += shx<32>(l); inv[j] = __builtin_amdgcn_rcpf(l); }
    const float inv1l = lam * inv[1];
    float ss = 0.f;
#pragma unroll
    for (int d = 0; d < 8; ++d)
#pragma unroll
        for (int e = 0; e < 4; ++e) { const float o = O[0][d][e] * inv[0] - O[1][d][e] * inv1l; O[0][d][e] = o; ss += o * o; }
    ss += shx<16>(ss); ss += shx<32>(ss);
    const float r = oml * __builtin_amdgcn_rsqf(ss * (1.0f / 128.0f) + EPS);
    unsigned long long ov[8];
#pragma unroll
    for (int d = 0; d < 8; ++d) ov[d] = (unsigned long long)pk2(O[0][d][0] * r * nwv[d][0], O[0][d][1] * r * nwv[d][1]) | ((unsigned long long)pk2(O[0][d][2] * r * nwv[d][2], O[0][d][3] * r * nwv[d][3]) << 32);
#pragma unroll
    for (int d = 0; d < 8; ++d) *(unsigned long long*)(MIX + (rowbase + qrow) * D + 512 + h * 128 + 16 * d + 4 * rq) = ov[d];
}

template <int NW> DI void dn1_unit(const Params& P, const Frame& F, int cidx) {
    constexpr int NT = NW * 64;
    unsigned char* ws = P.ws;
    const int bh = cidx >> 5, n = cidx & 31, b = bh >> 2, h = bh & 3; const size_t r0 = (size_t)b * SEQ + 64 * n;
    const bf16* ZC = (const bf16*)(ws + WS_T + T_ZC); const float* GD = (const float*)(ws + WS_GD);
    LAS unsigned char* Qs = F.lds + 16896; LAS unsigned char* Ks = F.lds + 34304; LAS unsigned char* Vs = F.lds + 51712;
    LAS float* Am = (LAS float*)(F.lds); LAS float* gcs = (LAS float*)(F.lds + 16384); LAS float* bts = (LAS float*)(F.lds + 16640);
    const int lane = F.lane, c = lane & 15, rq = lane >> 4;
    for (int id = F.tid; id < 3072; id += NT) { const int which = id >> 10, rem = id & 1023, row = rem >> 4, ch = rem & 15;
        *(LAS u32x4*)(Qs + which * 17408 + row * 272 + ch * 16) = *(const u32x4*)(ZC + (r0 + row) * 2560 + which * 512 + h * 128 + ch * 8); }
    if (F.tid < 64) { bts[F.tid] = GD[(r0 + F.tid) * 16 + h]; const float gc = wave_incl_sum(GD[(r0 + F.tid) * 16 + 4 + h], lane); gcs[F.tid] = gc;
        if (lane == 63) ((float*)(ws + WS_DNGL))[cidx] = __expf(gc); }
    __syncthreads();
    bf16* ATT = (bf16*)(ws + WS_T + T_ATT) + (size_t)cidx * 4096;
    for (int ti = 0; ti < 32 / NW; ++ti) {
        const int idx = F.wave * (32 / NW) + ti, isqk = idx >> 4, mt = (idx & 15) >> 2, nt = idx & 3;
        if (!isqk && mt < nt) continue;
        f32x4 a = (f32x4){0.f, 0.f, 0.f, 0.f};
        if (mt >= nt) {
#pragma unroll
            for (int ks = 0; ks < 4; ++ks) a = MFMA16(frag_row(isqk ? Qs : Ks, 272, 16 * mt, 32 * ks, lane), frag_row(Ks, 272, 16 * nt, 32 * ks, lane), a);
        }
        const int j = 16 * nt + c; const float gj = gcs[j];
#pragma unroll
        for (int e = 0; e < 4; ++e) { const int i = 16 * mt + 4 * rq + e; const float dec = __expf(gcs[i] - gj);
            if (!isqk) Am[i * 64 + j] = (i > j) ? bts[i] * a[e] * dec : 0.f;
            else ATT[i * 64 + j] = (bf16)f2bf((i >= j) ? a[e] * dec : 0.f); }
    }
    __syncthreads();
    if (NW == 4 || F.wave < 4) {
        const int cc = F.tid, d = cc & 127; const bool isw = cc >= 128;
        const LAS unsigned char* srcT = (isw ? Ks : Vs) + d * 2;
        float* up = (float*)(ws + WS_T + T_U) + r0 * 512 + h * 128 + d; bf16* wp = (bf16*)(ws + WS_T + T_W) + r0 * 512 + h * 128 + d;
        float x[64];
#pragma unroll
        for (int i = 0; i < 64; ++i) {
            const float gm = isw ? __expf(gcs[i]) : 1.0f;
            float acc = bf2f(*(const LAS bf16*)(srcT + i * 272)) * bts[i] * gm;
            float pa[4] = {0.f, 0.f, 0.f, 0.f};
#pragma unroll
            for (int j4 = 0; j4 < (i + 3) / 4; ++j4) { const f32x4 av = *(const LAS f32x4*)(Am + i * 64 + 4 * j4);
#pragma unroll
                for (int e = 0; e < 4; ++e) if (4 * j4 + e < i) pa[e] += av[e] * x[4 * j4 + e]; }
            acc -= (pa[0] + pa[1]) + (pa[2] + pa[3]);
            x[i] = acc;
            if (isw) *wp = (bf16)f2bf(acc); else *up = acc;
            up += 512; wp += 512; asm volatile("" : "+v"(up), "+v"(wp));
        }
    }
    if (NW == 4 || F.wave >= 4) {
        const int t = (NW == 4) ? F.tid : F.tid - 256;
        bf16* QG = (bf16*)(ws + WS_T + T_QG); bf16* KGT = (bf16*)(ws + WS_T + T_KGT) + (size_t)cidx * 8192;
        for (int idx = t; idx < 1024; idx += 256) { const int row = idx >> 4, ch = idx & 15; const u32x4 q = *(const LAS u32x4*)(Qs + row * 272 + ch * 16); const float eg = __expf(gcs[row]);
            u32x4 o; o.x = pk2(bflo(q.x) * eg, bfhi(q.x) * eg); o.y = pk2(bflo(q.y) * eg, bfhi(q.y) * eg); o.z = pk2(bflo(q.z) * eg, bfhi(q.z) * eg); o.w = pk2(bflo(q.w) * eg, bfhi(q.w) * eg);
            *(u32x4*)(QG + (r0 + row) * 512 + h * 128 + ch * 8) = o; }
        const float glast = gcs[63];
        for (int idx = t; idx < 1024; idx += 256) { const int dd = idx >> 3, ic = idx & 7; float v[8];
#pragma unroll
            for (int e = 0; e < 8; ++e) { const int i = 8 * ic + e; v[e] = bf2f(*(const LAS bf16*)(Ks + i * 272 + dd * 2)) * __expf(glast - gcs[i]); }
            u32x4 o; o.x = pk2(v[0], v[1]); o.y = pk2(v[2], v[3]); o.z = pk2(v[4], v[5]); o.w = pk2(v[6], v[7]);
            *(u32x4*)(KGT + dd * 64 + 8 * ic) = o; }
    }
    __syncthreads();
}

template <int NW> DI void ml1_unit(const Params& P, const Frame& F, int cidx) {
    constexpr int NT = NW * 64;
    unsigned char* ws = P.ws;
    const int bh = cidx >> 5, n = cidx & 31, b = bh >> 2, h = bh & 3; const size_t r0 = (size_t)b * SEQ + 64 * n;
    const bf16* Z = (const bf16*)(ws + WS_T + T_Z); const bf16* ZC = (const bf16*)(ws + WS_T + T_ZC); const float* MLS = (const float*)(ws + WS_MLS);
    LAS unsigned char* Vs = F.lds; LAS unsigned char* KWs = F.lds + 17408;
    const int lane = F.lane, c = lane & 15, rq = lane >> 4;
    LAS float* wl = (LAS float*)(F.lds + 34816);
    { const float* GD = (const float*)(ws + WS_GD);
      if (F.tid < 64) { const float lf = GD[(r0 + F.tid) * 16 + 12 + h], ip = GD[(r0 + F.tid) * 16 + 8 + h]; const float e = ip - wave_incl_sum(lf, lane); wl[F.tid] = __expf(e - wave_max(e)); } }
    __syncthreads();
    for (int id = F.tid; id < 2048; id += NT) { const int which = id >> 10, rem = id & 1023, row = rem >> 4, ch = rem & 15;
        if (which == 0) *(LAS u32x4*)(Vs + row * 272 + ch * 16) = *(const u32x4*)(Z + (r0 + row) * NZ + 6144 + h * 128 + ch * 8);
        else { const u32x4 k = *(const u32x4*)(ZC + (r0 + row) * 2560 + 2048 + h * 128 + ch * 8); const float w = wl[row];
            u32x4 o; o.x = pk2(bflo(k.x) * w, bfhi(k.x) * w); o.y = pk2(bflo(k.y) * w, bfhi(k.y) * w); o.z = pk2(bflo(k.z) * w, bfhi(k.z) * w); o.w = pk2(bflo(k.w) * w, bfhi(k.w) * w);
            *(LAS u32x4*)(KWs + row * 272 + ch * 16) = o; } }
    __syncthreads();
    float* DCT = (float*)(ws + WS_T + T_DCT) + (size_t)cidx * 16512;
    const unsigned Va = (unsigned)(size_t)Vs, Ka = (unsigned)(size_t)KWs;
#pragma unroll
    for (int mi = 0; mi < 8 / NW; ++mi) { const int mt = F.wave + NW * mi;
        bf16x8 af[2];
#pragma unroll
        for (int ks = 0; ks < 2; ++ks) af[ks] = frag_tr(Va, 272, 32 * ks, 16 * mt, lane);
#pragma unroll
        for (int nt = 0; nt < 8; ++nt) { f32x4 a = (f32x4){0.f, 0.f, 0.f, 0.f};
#pragma unroll
            for (int ks = 0; ks < 2; ++ks) a = MFMA16(af[ks], frag_tr(Ka, 272, 32 * ks, 16 * nt, lane), a);
#pragma unroll
            for (int e = 0; e < 4; ++e) DCT[(16 * mt + 4 * rq + e) * 128 + 16 * nt + c] = a[e]; } }
    if (F.tid < 128) { float s = 0.f; for (int j = 0; j < 64; ++j) s += bf2f(*(const LAS bf16*)(KWs + j * 272 + F.tid * 2)); DCT[128 * 128 + F.tid] = s; }
    __syncthreads();
}

DI void ml2_scan(const Params& P, int gt, int NGT) {
    unsigned char* ws = P.ws;
    const float* DCT = (const float*)(ws + WS_T + T_DCT); bf16* CST = (bf16*)(ws + WS_T + T_CST); const float* MLCS = (const float*)(ws + WS_MLCS);
    for (int g = gt; g < 32 * 4128; g += NGT) { const int bh = g / 4128, idx = (g % 4128) * 4; f32x4 cst = (f32x4){0.f, 0.f, 0.f, 0.f};
#pragma unroll 1
        for (int n0 = 0; n0 < 32; n0 += 8) { f32x4 d[8]; float cs[8];
#pragma unroll
            for (int k = 0; k < 8; ++k) { const int cid = bh * 32 + n0 + k; d[k] = *(const f32x4*)(DCT + (size_t)cid * 16512 + idx) * MLCS[NCHUNK + cid]; cs[k] = MLCS[cid]; }
#pragma unroll
            for (int k = 0; k < 8; ++k) { const int cid = bh * 32 + n0 + k;
                *(unsigned long long*)(CST + (size_t)cid * 18432 + idx) = (unsigned long long)pk2(cst[0], cst[1]) | ((unsigned long long)pk2(cst[2], cst[3]) << 32);
                cst = cs[k] * cst + d[k]; } } }
}

DI void head_gate_load(const Frame& F, const bf16* gsrc  , u32x4& g0, u32x4& g1) {
    const int row = F.tid >> 3, seg = F.tid & 7;
    g0 = *(const u32x4*)(gsrc + (size_t)row * NZ + 16 * seg); g1 = *(const u32x4*)(gsrc + (size_t)row * NZ + 16 * seg + 8);
}
DI void head_nw_load(const Frame& F, const float* nw, f32x4 (&nwv)[4]) { const int seg = F.tid & 7;
#pragma unroll
    for (int q = 0; q < 4; ++q) nwv[q] = *(const f32x4*)(nw + 16 * seg + 4 * q); }
template <int GATE> DI void head_norm_store(const Frame& F, const LAS float* Hs, const f32x4 (&nwv)[4], const u32x4 g0, const u32x4 g1, bf16* dst  ) {
    const int row = F.tid >> 3, seg = F.tid & 7;
    float v[16]; float ss = 0.f;
#pragma unroll
    for (int e = 0; e < 16; ++e) { v[e] = Hs[row * 132 + 16 * seg + e]; ss += v[e] * v[e]; }
    ss += shx<1>(ss); ss += shx<2>(ss); ss += shx<4>(ss);
    const float r = 1.0f / sqrtf(ss * (1.0f / 128.0f) + EPS);
    float gt[16] = {bflo(g0.x), bfhi(g0.x), bflo(g0.y), bfhi(g0.y), bflo(g0.z), bfhi(g0.z), bflo(g0.w), bfhi(g0.w), bflo(g1.x), bfhi(g1.x), bflo(g1.y), bfhi(g1.y), bflo(g1.z), bfhi(g1.z), bflo(g1.w), bfhi(g1.w)};
#pragma unroll
    for (int e = 0; e < 16; ++e) v[e] = v[e] * r * nwv[e >> 2][e & 3] * (GATE == 0 ? siluf_(gt[e]) : sigmoidf_(gt[e]));
    u32x4 o0, o1; o0.x = pk2(v[0], v[1]); o0.y = pk2(v[2], v[3]); o0.z = pk2(v[4], v[5]); o0.w = pk2(v[6], v[7]); o1.x = pk2(v[8], v[9]); o1.y = pk2(v[10], v[11]); o1.z = pk2(v[12], v[13]); o1.w = pk2(v[14], v[15]);
    *(u32x4*)(dst + (size_t)row * D + 16 * seg) = o0; *(u32x4*)(dst + (size_t)row * D + 16 * seg + 8) = o1;
}

struct Dn2A { bf16x8 wf[4]; };
struct Dn2B { bf16x8 qf[4], af[2], kf[2]; float gl; };
DI void dn2_load_a(const Params& P, const Frame& F, int bh, int n, Dn2A& o) {
    unsigned char* ws = P.ws;
    const int b = bh >> 2, h = bh & 3, lane = F.lane, c = lane & 15, rq = lane >> 4, w = F.wave, mt = w >> 1;
    const size_t r0 = (size_t)b * SEQ + 64 * n;
    const bf16* W = (const bf16*)(ws + WS_T + T_W);
#pragma unroll
    for (int ks = 0; ks < 4; ++ks) o.wf[ks] = *(const bf16x8*)(W + (r0 + 16 * mt + c) * 512 + h * 128 + 32 * ks + 8 * rq);
}
DI void dn2_load_u(const Params& P, const Frame& F, int bh, int n, float (&u)[4][4]) {
    unsigned char* ws = P.ws;
    const int b = bh >> 2, h = bh & 3, lane = F.lane, c = lane & 15, rq = lane >> 4, w = F.wave, mt = w >> 1, ntb = (w & 1) * 4;
    const size_t r0 = (size_t)b * SEQ + 64 * n; const float* U = (const float*)(ws + WS_T + T_U);
#pragma unroll
    for (int t = 0; t < 4; ++t)
#pragma unroll
        for (int e = 0; e < 4; ++e) u[t][e] = U[(r0 + 16 * mt + 4 * rq + e) * 512 + h * 128 + 16 * (ntb + t) + c];
}
DI void dn2_load_b(const Params& P, const Frame& F, int bh, int n, Dn2B& o) {
    unsigned char* ws = P.ws;
    const int b = bh >> 2, h = bh & 3, lane = F.lane, c = lane & 15, rq = lane >> 4, w = F.wave, mt = w >> 1;
    const int cid = bh * 32 + n; const size_t r0 = (size_t)b * SEQ + 64 * n;
    const bf16* QG = (const bf16*)(ws + WS_T + T_QG);
    const bf16* ATT = (const bf16*)(ws + WS_T + T_ATT) + (size_t)cid * 4096; const bf16* KGT = (const bf16*)(ws + WS_T + T_KGT) + (size_t)cid * 8192;
    o.gl = ((const float*)(ws + WS_DNGL))[cid];
#pragma unroll
    for (int ks = 0; ks < 4; ++ks) o.qf[ks] = *(const bf16x8*)(QG + (r0 + 16 * mt + c) * 512 + h * 128 + 32 * ks + 8 * rq);
#pragma unroll
    for (int ks = 0; ks < 2; ++ks) { o.af[ks] = *(const bf16x8*)(ATT + (16 * mt + c) * 64 + 32 * ks + 8 * rq); o.kf[ks] = *(const bf16x8*)(KGT + (16 * w + c) * 64 + 32 * ks + 8 * rq); }
}
DI void dn2_block(const Params& P, const Frame& F, int L, int bh) {
    unsigned char* ws = P.ws;
    const int b = bh >> 2, h = bh & 3, lane = F.lane, c = lane & 15, rq = lane >> 4, w = F.wave;
    LAS unsigned char* St0 = F.lds; LAS unsigned char* VnT = F.lds + 69632; LAS float* Os = (LAS float*)(F.lds + 88064);
    bf16* MIX = (bf16*)(ws + WS_T + T_MIX);
    for (int i = F.tid; i < 34816 / 16; i += NTHR) ((LAS u32x4*)St0)[i] = (u32x4){0u, 0u, 0u, 0u};
    f32x4 sreg[8];
#pragma unroll
    for (int nt = 0; nt < 8; ++nt) sreg[nt] = (f32x4){0.f, 0.f, 0.f, 0.f};
    LAS float* nws = (LAS float*)(F.lds + 121856); if (F.tid < 128) nws[F.tid] = P.in[I_DN_NORM][L * 128 + F.tid];
    Dn2A cur, nxt; Dn2B ob; u32x4 gp0 = (u32x4){0u, 0u, 0u, 0u}, gp1 = gp0;
    dn2_load_a(P, F, bh, 0, cur);
    __syncthreads();
    const int mt = w >> 1, ntb = (w & 1) * 4;
#pragma unroll 1
    for (int n = 0; n < 32; ++n) {
        const int p = n & 1; const size_t r0 = (size_t)b * SEQ + 64 * n;
        const LAS unsigned char* Sp = St0 + p * 34816; LAS unsigned char* Sn = St0 + (1 - p) * 34816;
        float uu[4][4]; dn2_load_u(P, F, bh, n, uu);
        u32x4 g0, g1; head_gate_load(F, (const bf16*)(ws + WS_T + T_Z) + r0 * NZ + 2560 + h * 128, g0, g1);
        dn2_load_b(P, F, bh, n, ob);
        dn2_load_a(P, F, bh, n + 1 < 32 ? n + 1 : n, nxt);
        f32x4 va[4];
#pragma unroll
        for (int t = 0; t < 4; ++t) { const int nt = ntb + t; f32x4 a = (f32x4){0.f, 0.f, 0.f, 0.f};
#pragma unroll
            for (int ks = 0; ks < 4; ++ks) a = MFMA16(cur.wf[ks], frag_row(Sp, 272, 16 * nt, 32 * ks, lane), a);
            va[t] = a; }
        if (n > 0) { f32x4 nwv[4]; const int seg = F.tid & 7;
#pragma unroll
            for (int q = 0; q < 4; ++q) nwv[q] = *(const LAS f32x4*)(nws + 16 * seg + 4 * q);
            head_norm_store<0>(F, Os, nwv, gp0, gp1, MIX + (r0 - 64) * D + h * 128); }
#pragma unroll
        for (int t = 0; t < 4; ++t) { const int nt = ntb + t;
            *(LAS unsigned long long*)(VnT + (16 * nt + c) * 144 + (16 * mt + 4 * rq) * 2) = (unsigned long long)pk2(uu[t][0] - va[t][0], uu[t][1] - va[t][1]) | ((unsigned long long)pk2(uu[t][2] - va[t][2], uu[t][3] - va[t][3]) << 32); }
        lds_barrier();
#pragma unroll
        for (int t = 0; t < 4; ++t) { const int nt = ntb + t; f32x4 a = (f32x4){0.f, 0.f, 0.f, 0.f};
#pragma unroll
            for (int ks = 0; ks < 4; ++ks) a = MFMA16(ob.qf[ks], frag_row(Sp, 272, 16 * nt, 32 * ks, lane), a);
#pragma unroll
            for (int ks = 0; ks < 2; ++ks) a = MFMA16(ob.af[ks], frag_row(VnT, 144, 16 * nt, 32 * ks, lane), a);
#pragma unroll
            for (int e = 0; e < 4; ++e) Os[(16 * mt + 4 * rq + e) * 132 + 16 * nt + c] = a[e]; }
#pragma unroll
        for (int nt = 0; nt < 8; ++nt) { f32x4 a = sreg[nt] * ob.gl;
#pragma unroll
            for (int ks = 0; ks < 2; ++ks) a = MFMA16(ob.kf[ks], frag_row(VnT, 144, 16 * nt, 32 * ks, lane), a);
            sreg[nt] = a;
            *(LAS unsigned long long*)(Sn + (16 * nt + c) * 272 + (16 * w + 4 * rq) * 2) = (unsigned long long)pk2(a[0], a[1]) | ((unsigned long long)pk2(a[2], a[3]) << 32); }
        lds_barrier();
        gp0 = g0; gp1 = g1; cur = nxt;
    }
    { f32x4 nwv[4]; const int seg = F.tid & 7;
#pragma unroll
      for (int q = 0; q < 4; ++q) nwv[q] = *(const LAS f32x4*)(nws + 16 * seg + 4 * q);
      head_norm_store<0>(F, Os, nwv, gp0, gp1, MIX + ((size_t)b * SEQ + 64 * 31) * D + h * 128); }
    __syncthreads();
}

DI void ml3_unit(const Params& P, const Frame& F, int L, int cidx) {
    unsigned char* ws = P.ws;
    const int bh = cidx >> 5, n = cidx & 31, b = bh >> 2, h = bh & 3; const size_t r0 = (size_t)b * SEQ + 64 * n;
    const bf16* Z = (const bf16*)(ws + WS_T + T_Z); const bf16* ZC = (const bf16*)(ws + WS_T + T_ZC); const float* MLS = (const float*)(ws + WS_MLS);
    const bf16* CST = (const bf16*)(ws + WS_T + T_CST) + (size_t)cidx * 18432; bf16* MIX = (bf16*)(ws + WS_T + T_MIX);
    LAS unsigned char* Qs = F.lds; LAS unsigned char* Ks = F.lds + 17408; LAS unsigned char* Vx = F.lds + 34816; LAS unsigned char* Cs = F.lds + 54272; LAS unsigned char* Sm = F.lds + 93440;
    LAS float* sA = (LAS float*)(F.lds + 102656); LAS float* ej = sA + 64; LAS float* inter = sA + 128; LAS float* flo = sA + 192; LAS float* den1 = sA + 256; LAS float* qn = sA + 320;
    LAS float* Hs = (LAS float*)F.lds;
    const int lane = F.lane, c = lane & 15, rq = lane >> 4, w = F.wave;
    for (int id = F.tid; id < 3072; id += NTHR) { const int which = id >> 10, rem = id & 1023, row = rem >> 4, ch = rem & 15;
        if (which == 0) *(LAS u32x4*)(Qs + row * 272 + ch * 16) = *(const u32x4*)(ZC + (r0 + row) * 2560 + 1536 + h * 128 + ch * 8);
        else if (which == 1) *(LAS u32x4*)(Ks + row * 272 + ch * 16) = *(const u32x4*)(ZC + (r0 + row) * 2560 + 2048 + h * 128 + ch * 8);
        else *(LAS u32x4*)(Vx + row * 304 + ch * 16) = *(const u32x4*)(Z + (r0 + row) * NZ + 6144 + h * 128 + ch * 8); }
    if (F.tid < 128) { const int row = F.tid >> 1, which = F.tid & 1; *(LAS u32x4*)(Vx + row * 304 + 256 + which * 16) = (u32x4){which == 0 ? 0x00003F80u : 0u, 0u, 0u, 0u}; }
    for (int id = F.tid; id < 2304; id += NTHR) { const int row = id >> 4, ch = id & 15; *(LAS u32x4*)(Cs + row * 272 + ch * 16) = *(const u32x4*)(CST + row * 128 + ch * 8); }
    if (F.tid < 64) { const float* s = MLS + ((r0 + F.tid) * 4 + h) * 8; ej[F.tid] = s[0]; sA[F.tid] = s[1]; inter[F.tid] = s[2]; flo[F.tid] = s[3]; }
    __syncthreads();
#pragma unroll
    for (int ti = 0; ti < 2; ++ti) { const int idx = 2 * w + ti, mt = idx >> 2, nt = idx & 3; f32x4 a = (f32x4){0.f, 0.f, 0.f, 0.f};
        if (mt >= nt) {
#pragma unroll
            for (int ks = 0; ks < 4; ++ks) a = MFMA16(frag_row(Qs, 272, 16 * mt, 32 * ks, lane), frag_row(Ks, 272, 16 * nt, 32 * ks, lane), a);
        }
        const int j = 16 * nt + c; const float e_j = ej[j];
#pragma unroll
        for (int e = 0; e < 4; ++e) { const int i = 16 * mt + 4 * rq + e; *(LAS bf16*)(Sm + i * 144 + j * 2) = (bf16)f2bf((i >= j) ? a[e] * __expf(sA[i] + e_j) : 0.f); } }
    const int mt = w >> 1, ntb = (w & 1) * 4;
    f32x4 acc2[4], acc1[4], a29 = (f32x4){0.f, 0.f, 0.f, 0.f}, a19 = (f32x4){0.f, 0.f, 0.f, 0.f};
    { bf16x8 qf[4];
#pragma unroll
      for (int ks = 0; ks < 4; ++ks) qf[ks] = frag_row(Qs, 272, 16 * mt, 32 * ks, lane);
#pragma unroll
      for (int t = 0; t < 4; ++t) { f32x4 a = (f32x4){0.f, 0.f, 0.f, 0.f};
#pragma unroll
          for (int ks = 0; ks < 4; ++ks) a = MFMA16(qf[ks], frag_row(Cs, 272, 16 * (ntb + t), 32 * ks, lane), a);
          acc2[t] = a; }
      if ((w & 1) == 0) {
#pragma unroll
          for (int ks = 0; ks < 4; ++ks) a29 = MFMA16(qf[ks], frag_row(Cs, 272, 128, 32 * ks, lane), a29); } }
    __syncthreads();
    { const unsigned Va = (unsigned)(size_t)Vx; bf16x8 sf[2];
#pragma unroll
      for (int ks = 0; ks < 2; ++ks) sf[ks] = frag_row(Sm, 144, 16 * mt, 32 * ks, lane);
#pragma unroll
      for (int t = 0; t < 4; ++t) { f32x4 a = (f32x4){0.f, 0.f, 0.f, 0.f};
#pragma unroll
          for (int ks = 0; ks < 2; ++ks) a = MFMA16(sf[ks], frag_tr(Va, 304, 32 * ks, 16 * (ntb + t), lane), a);
          acc1[t] = a; }
      if ((w & 1) == 0) {
#pragma unroll
          for (int ks = 0; ks < 2; ++ks) a19 = MFMA16(sf[ks], frag_tr(Va, 304, 32 * ks, 128, lane), a19);
          if (c == 0) {
#pragma unroll
              for (int e = 0; e < 4; ++e) { den1[16 * mt + 4 * rq + e] = a19[e]; qn[16 * mt + 4 * rq + e] = a29[e]; } } } }
    __syncthreads();
#pragma unroll
    for (int t = 0; t < 4; ++t)
#pragma unroll
        for (int e = 0; e < 4; ++e) { const int i = 16 * mt + 4 * rq + e; const float it = inter[i], den = den1[i] + it * qn[i];
            Hs[i * 132 + 16 * (ntb + t) + c] = (acc1[t][e] + it * acc2[t][e]) / fmaxf(fabsf(den), flo[i]); }
    __syncthreads();
    { u32x4 g0, g1; f32x4 nwv[4]; head_gate_load(F, Z + r0 * NZ + 6656 + h * 128, g0, g1); head_nw_load(F, P.in[I_ML_NORM] + L * 128, nwv); head_norm_store<1>(F, Hs, nwv, g0, g1, MIX + r0 * D + 1536 + h * 128); }
    __syncthreads();
}

constexpr int NPH = 28;
#ifndef MK_SPLIT
#define MK_SPLIT 0
#endif

#define PH_SETUP() { int l_ = __builtin_amdgcn_mbcnt_hi(~0u, __builtin_amdgcn_mbcnt_lo(~0u, 0u)); asm volatile("" : "+v"(l_)); F.lane = l_; F.tid = F.wave * 64 + l_; }
#define PH_BEGIN(k, kind) if (lo <= (k) && (k) < hi) { PH_SETUP()
#define PH_END(k) if ((k) + 1 < hi) xcd_barrier(bar); }
template <int L> DI void layer_phases(const Params& P, Frame& F, const XcdBarrier& bar, int lo, int hi) {
    unsigned char* ws = P.ws;
    LAS unsigned char* ring = F.lds;
    bf16* HN = (bf16*)(ws + WS_HN);
    bf16* H = (bf16*)(ws + WS_H) + (size_t)L * M * D; bf16* Hnext = (bf16*)(ws + WS_H) + (size_t)M * D;
        const int pb = 1 + 13 * L;
        const void* hin = (L == 0) ? (const void*)P.in[I_X] : (const void*)H;
        PH_BEGIN(pb + 0, 0) norm_phase<1, L == 1>(P, F, L, hin, P.in[I_ATTN_NORM] + L * D, false); PH_END(pb + 0)
        PH_BEGIN(pb + 1, 1) {
            const int gg = (L == 0) ? GRID - NCONV : GRID;
            if (F.bid < gg) {
                pg8::Gemm g{HN, (const bf16*)(ws + WS_WIN) + (size_t)L * NZ * D, M, NZ, D, 0, 0}; pg8::StaticOrder S; S.init(M, NZ, gg, F.bid);
                pg8::EpiBf16Plain E{(bf16*)(ws + WS_T + T_Z), NZ};
                pg8::gemm_phase<pg8::EpiBf16Plain, pg8::StaticOrder, true, true>(ring, g, S, E, F.wave); }
            else prologue_phase<1>(P, F); }
        PH_END(pb + 1)
        PH_BEGIN(pb + 2, 2) {
            prep_phase(P, F, L);
            static_assert(GRID * 64 == M && SEQ / 64 == 32, "one 64-row chunk per workgroup");
            Frame Hf = F; const int half = F.wave >> 2, cb = F.bid >> 5, cn = F.bid & 31; Hf.tid = F.tid & 255; Hf.wave = F.wave & 3;
            Hf.lds = F.lds + half * 69120;
#pragma unroll 1
            for (int hh = 0; hh < 2; ++hh) dn1_unit<4>(P, Hf, ((cb * 4 + 2 * half + hh) * 32 + cn));
            Hf.lds = F.lds + half * 35328;
#pragma unroll 1
            for (int hh = 0; hh < 2; ++hh) ml1_unit<4>(P, Hf, ((cb * 4 + 2 * half + hh) * 32 + cn)); }
        PH_END(pb + 2)
        PH_BEGIN(pb + 4, 4) {
            if (F.bid < 32) dn2_block(P, F, L, F.bid); else ml2_scan(P, (F.bid - 32) * NTHR + F.tid, (F.G - 32) * NTHR);
            const float li = (L == 0) ? 0.2f : 0.35550906759f;
            const float d1 = wave_sum(P.in[I_LQ1][L * 64 + F.lane] * P.in[I_LK1][L * 64 + F.lane]), d2 = wave_sum(P.in[I_LQ2][L * 64 + F.lane] * P.in[I_LK2][L * 64 + F.lane]);
            const float lam = __expf(d1) - __expf(d2) + li;
            unsigned* qctr = (unsigned*)(ws + WS_CTL) + CW_QUEUE + 64 * L;
            for (;;) {
                __syncthreads();
                if (F.tid == 0) F.MISC[24] = __hip_atomic_fetch_add(qctr, 1u, __ATOMIC_RELAXED, __HIP_MEMORY_SCOPE_AGENT);
                __syncthreads();
                const int u = (int)F.MISC[24];
                if (u >= 1024) break;
                const int bh = u & 63; attn_block(P, F, L, bh >> 3, bh & 7, 15 - (u >> 6), lam, 1.0f - li); } }
        PH_END(pb + 4)
        PH_BEGIN(pb + 5, 5) for (int u = F.bid; u < NCHUNK; u += F.G) ml3_unit(P, F, L, u); PH_END(pb + 5)
        PH_BEGIN(pb + 6, 6) {
            pg8::Gemm g{(const bf16*)(ws + WS_T + T_MIX), (const bf16*)(ws + WS_WOUT) + (size_t)L * D * D, M, D, D, 0, 0}; pg8::StaticOrder S; S.init(M, D, F.G, F.bid);
            pg8::EpiRes<1, L == 0, L == 0> E{H, hin, nullptr, D, (float*)(ws + WS_T + T_SS), (LAS float*)(F.lds + MISC_OFF + 1024), nullptr};
            pg8::gemm_phase<pg8::EpiRes<1, L == 0, L == 0>, pg8::StaticOrder, true, true>(ring, g, S, E, F.wave); }
        PH_END(pb + 6)
        if (L == 0) {
            PH_BEGIN(pb + 9, 9) {
                rstd_fill(P, F);
                pg8::Gemm g{H, (const bf16*)(ws + WS_WGU), M, 2 * DFF, D, 0, 0}; pg8::StaticOrder S; S.init(M, 2 * DFF, F.G, F.bid);
                pg8::EpiSwiGLU<true, false, true> E{(unsigned char*)(ws + WS_T + T_ACT), DFF, (float)(1 << LS_ACT), (const LAS float*)(F.lds + LDS_RSTD)};
                pg8::gemm_phase<pg8::EpiSwiGLU<true, false, true>, pg8::StaticOrder, true, true, false>(ring, g, S, E, F.wave); }
            PH_END(pb + 9)
            PH_BEGIN(pb + 10, 10) {
                pg8::Gemm g{(const bf16*)(ws + WS_T + T_ACT), (const bf16*)(ws + WS_WD), M, D, DFF / 2, SB(LS_ACT), SB(LS_WD)}; pg8::StaticOrder S; S.init(M, D, F.G, F.bid);
                pg8::EpiRes<1, false, true> E{H, H, nullptr, D, (float*)(ws + WS_T + T_SS), (LAS float*)(F.lds + MISC_OFF + 1024), nullptr};
                pg8::gemm_phase<pg8::EpiRes<1, false, true>, pg8::StaticOrder, true, true, true>(ring, g, S, E, F.wave); }
            PH_END(pb + 10)
        } else {
            PH_BEGIN(pb + 7, 7) norm_phase<2, true>(P, F, L, H, P.in[I_FFN_NORM] + L * D, false); PH_END(pb + 7)
            PH_BEGIN(pb + 8, 8) moe_gather_phase(P, F); PH_END(pb + 8)
            PH_BEGIN(pb + 9, 9) {
                const int* TILE_E = (const int*)(ws + WS_TILEE); const int ntile = __builtin_amdgcn_readfirstlane(TILE_E[255]);
                unsigned* mcnt = (unsigned*)(ws + WS_CTL) + CW_MOECNT;
                { pg8::Gemm g{(const bf16*)(ws + WS_T + T_APERM), (const bf16*)(ws + WS_MGU), ntile * 256, 2 * DFF, D / 2, SB(LS_HN), SB(LS_WGU)};
                  pg8::MoeGuOrder S; S.init(ntile * 256, 2 * DFF, F.G, F.bid); S.tile_e = TILE_E; S.estride = (size_t)2 * DFF * D;
                  const int nd = ntile * (D / 256), rmax = (nd + F.G - 1) / F.G; int Hh = nd - (rmax - 1) * F.G; if (Hh >= F.G) Hh = 0;
                  S.H = Hh; S.NL = F.G - Hh; S.gH = (S.nwg - 3 * S.NL) / F.G; if (S.gH < 0) S.gH = 0; S.cnt = mcnt; S.pend = -1; S.lead = (F.tid == 0);
                  pg8::EpiSwiGLU<true, true> E{(unsigned char*)(ws + WS_T + T_ACT), DFF, (float)(1 << LS_ACT), nullptr};
                  pg8::gemm_phase<pg8::EpiSwiGLU<true, true>, pg8::MoeGuOrder, true, true, true>(ring, g, S, E, F.wave);
                  S.flush(); }
                { pg8::Gemm g{(const bf16*)(ws + WS_T + T_ACT), (const bf16*)(ws + WS_MD), ntile * 256, D, DFF / 2, SB(LS_ACT), SB(LS_WD)};
                  pg8::MoeDnOrder S; S.init(ntile * 256, D, F.G, F.bid); S.tile_e = TILE_E; S.estride = (size_t)D * DFF;
                  S.cnt = mcnt; S.need = 2 * DFF / 256;
                  pg8::EpiBf16Plain E{(bf16*)(ws + WS_T + T_YPERM), D};
                  pg8::gemm_phase<pg8::EpiBf16Plain, pg8::MoeDnOrder, true, true, true>(ring, g, S, E, F.wave); } }
            PH_END(pb + 9)
        }
        if constexpr (L == 1) { PH_BEGIN(pb + 11, 11) norm_phase<3, true>(P, F, L, H, P.in[I_PLE_NORM] + L * D, true); PH_END(pb + 11) }
        PH_BEGIN(pb + 12, 12) {
            if constexpr (L == 0) rstd_fill(P, F);
            { int kple = PLE; asm volatile("" : "+s"(kple)); pg8::Gemm g{(const bf16*)(ws + WS_T + (L == 0 ? T_PB0 : T_PB)), (const bf16*)(ws + WS_WPP) + (size_t)L * D * PLE, M, D, kple, 0, 0}; pg8::StaticOrder S; S.init(M, D, F.G, F.bid);
              pg8::EpiBf16Plain E{(bf16*)(ws + WS_T + T_PP), D};
              pg8::gemm_phase<pg8::EpiBf16Plain, pg8::StaticOrder, true, true>(ring, g, S, E, F.wave); }
            { pg8::Gemm g{L == 0 ? H : HN, (const bf16*)(ws + WS_WPG) + (size_t)L * D * D, M, D, L == 1 ? D / 2 : D, L == 1 ? SB(LS_HN) : 0, L == 1 ? SB(LS_WGU) : 0}; pg8::StaticOrder S; S.init(M, D, F.G, F.bid);
              pg8::EpiRes<2, false, false, L == 0> E{L == 0 ? Hnext : H, H, (const bf16*)(ws + WS_T + T_PP), D, nullptr, nullptr, (const LAS float*)(F.lds + LDS_RSTD)};
              pg8::gemm_phase<pg8::EpiRes<2, false, false, L == 0>, pg8::StaticOrder, true, true, L == 1>(ring, g, S, E, F.wave); } }
        PH_END(pb + 12)
    }
__global__ void __launch_bounds__(NTHR, 2) fwd(Params P) {
    extern __shared__ __attribute__((aligned(16))) unsigned char lds_raw[];
    Frame F;
    F.lds = (LAS unsigned char*)lds_raw;
    F.MISC = (volatile LAS unsigned*)(F.lds + MISC_OFF);
    F.tid = threadIdx.x; F.lane = F.tid & 63; F.wave = __builtin_amdgcn_readfirstlane(F.tid >> 6);
    F.G = GRID; F.bid = blockIdx.x;
    unsigned char* ws = P.ws;
    for (int u = F.tid; u < (LDS_BYTES - MISC_OFF) / 4; u += NTHR) ((LAS unsigned*)(F.lds + MISC_OFF))[u] = 0u;
    __syncthreads();
    XcdBarrier bar = xcd_barrier_post((unsigned*)(ws + WS_CTL) + CW_BAR, F.MISC + 8);
    const int lo = P.ph_lo, hi = P.ph_hi;
    LAS unsigned char* ring = F.lds;
    bf16* HN = (bf16*)(ws + WS_HN); bf16* H = (bf16*)(ws + WS_H) + (size_t)M * D;

    PH_BEGIN(0, 13) prologue_phase<0>(P, F); PH_END(0)

    layer_phases<0>(P, F, bar, lo, hi);
    layer_phases<1>(P, F, bar, lo, hi);
    PH_BEGIN(27, 14) norm_phase<4, true>(P, F, 0, H, P.in[I_FINAL_NORM], false); PH_END(27)
#undef PH_BEGIN
#undef PH_END
}

extern "C" void kernel_launch(void* const* d_in, const int* in_sizes, int n_in, void* d_out, int out_size, void* d_ws, size_t ws_size, hipStream_t stream) {
    static int grid = 0;
    if (grid == 0) {
        if (n_in != 30 || out_size != M * D || ws_size < WS_END) { fprintf(stderr, "kernel_launch: unexpected shapes (n_in %d out %d ws %zu, need %zu)\n", n_in, out_size, ws_size, (size_t)WS_END); grid = -1; return; }
        int dev = 0, cus = 0, per_cu = 0;
        if (hipGetDevice(&dev) != hipSuccess || hipDeviceGetAttribute(&cus, hipDeviceAttributeMultiprocessorCount, dev) != hipSuccess) { grid = -1; return; }
        if (hipFuncSetAttribute((const void*)fwd, hipFuncAttributeMaxDynamicSharedMemorySize, LDS_BYTES) != hipSuccess) { fprintf(stderr, "kernel_launch: hipFuncSetAttribute failed\n"); grid = -1; return; }
        if (hipOccupancyMaxActiveBlocksPerMultiprocessor(&per_cu, (const void*)fwd, NTHR, LDS_BYTES) != hipSuccess || per_cu < 1) fprintf(stderr, "kernel_launch: occupancy query says %d\n", per_cu);
        (void)hipGetLastError();
        grid = GRID;
    }
    if (grid < 0) return;
    (void)hipMemsetAsync((char*)d_ws + WS_CTL, 0, CTL_ZERO_BYTES, stream);
    Params p{};
    for (int i = 0; i < 30; ++i) p.in[i] = (const float*)d_in[i];
    p.out = (float*)d_out; p.ws = (unsigned char*)d_ws;
#if MK_SPLIT
    for (int k = 0; k < NPH; ++k) { if (k == 1 + 8) continue; p.ph_lo = k; p.ph_hi = k + 1; hipLaunchKernelGGL(fwd, dim3(grid), dim3(NTHR), LDS_BYTES, stream, p); }
#else
    p.ph_lo = 0; p.ph_hi = NPH; hipLaunchKernelGGL(fwd, dim3(grid), dim3(NTHR), LDS_BYTES, stream, p);
#endif
}
```

```cpp
#include <hip/hip_runtime.h>
#include <cstdio>
#include <cstdint>

#define DI __device__ __forceinline__
#define LAS __attribute__((address_space(3)))
#define GAS __attribute__((address_space(1)))
typedef unsigned short bf16;
typedef short bf16x8 __attribute__((ext_vector_type(8)));
typedef short s16x4 __attribute__((ext_vector_type(4)));
typedef float f32x4 __attribute__((ext_vector_type(4)));
typedef float f32x2 __attribute__((ext_vector_type(2)));
typedef unsigned u32x4 __attribute__((ext_vector_type(4)));
typedef unsigned u32x2 __attribute__((ext_vector_type(2)));

DI unsigned f2bf(float f) { unsigned u = __builtin_bit_cast(unsigned, f); return (u + 0x7fffu + ((u >> 16) & 1u)) >> 16; }
typedef __bf16 bf16x2_t __attribute__((ext_vector_type(2)));
DI unsigned pk2(float lo, float hi) { const f32x2 v = {lo, hi}; return __builtin_bit_cast(unsigned, __builtin_convertvector(v, bf16x2_t)); }
DI float bf2f(unsigned short b) { return __builtin_bit_cast(float, ((unsigned)b) << 16); }
DI float bflo(unsigned u) { return __builtin_bit_cast(float, u << 16); }
DI float bfhi(unsigned u) { return __builtin_bit_cast(float, u & 0xffff0000u); }
DI unsigned pk4_fp8(float a, float b, float c, float d) { unsigned w = 0u; w = __builtin_amdgcn_cvt_pk_fp8_f32(a, b, w, false); w = __builtin_amdgcn_cvt_pk_fp8_f32(c, d, w, true); return w; }
template <int K> DI float shx(float v) {
    if constexpr (K == 1) return __builtin_bit_cast(float, __builtin_amdgcn_update_dpp(0, __builtin_bit_cast(int, v), 0xB1, 0xF, 0xF, true));
    else if constexpr (K == 2) return __builtin_bit_cast(float, __builtin_amdgcn_update_dpp(0, __builtin_bit_cast(int, v), 0x4E, 0xF, 0xF, true));
    else if constexpr (K == 32) return __shfl_xor(v, 32);
    else return __builtin_bit_cast(float, __builtin_amdgcn_ds_swizzle(__builtin_bit_cast(int, v), (K << 10) | 0x1F));
}
DI float wave_sum(float v) { v += shx<1>(v); v += shx<2>(v); v += shx<4>(v); v += shx<8>(v); v += shx<16>(v); v += shx<32>(v); return v; }
DI float wave_max(float v) { v = fmaxf(v, shx<1>(v)); v = fmaxf(v, shx<2>(v)); v = fmaxf(v, shx<4>(v)); v = fmaxf(v, shx<8>(v)); v = fmaxf(v, shx<16>(v)); v = fmaxf(v, shx<32>(v)); return v; }
DI float sigmoidf_(float x) { return __builtin_amdgcn_rcpf(1.0f + __expf(-x)); }
DI float siluf_(float x) { return x * __builtin_amdgcn_rcpf(1.0f + __expf(-x)); }
DI float softplusf_(float x) { return fmaxf(x, 0.f) + log1pf(__expf(-fabsf(x))); }
DI void lds_barrier() { asm volatile("s_waitcnt lgkmcnt(0)" ::: "memory"); __builtin_amdgcn_s_barrier(); asm volatile("" ::: "memory"); }
#define LDS_WAIT() asm volatile("s_waitcnt lgkmcnt(0)" ::: "memory")
#define VM_WAIT() asm volatile("s_waitcnt vmcnt(0)" ::: "memory")

#define MK_SPLIT 0
namespace pg8 {
#define PG8_LAS __attribute__((address_space(3)))
typedef unsigned short bf16_t;
typedef short bf16x8 __attribute__((ext_vector_type(8)));
typedef float f32x4 __attribute__((ext_vector_type(4)));
typedef unsigned u32x4 __attribute__((ext_vector_type(4)));
constexpr int BM = 256, BK = 64, HALF = 128, HTB = HALF * BK * 2  , STAGE_BYTES = 8 * HTB, NXCD = 8, WGM = 8;

__host__ __device__ __forceinline__ int lds_byte(int r, int c) { const int st = (r >> 4) * 2 + (c >> 5), rr = r & 15, cc = c & 31, ob = rr * 64 + cc * 2; return st * 1024 + (ob ^ (((ob >> 9) & 1) << 5)); }
__host__ __device__ __forceinline__ void stage_rc(int b, int& R, int& C) { const int st = b / 1024, sb = b % 1024, swz = sb ^ (((sb >> 9) & 1) << 5); R = (st >> 1) * 16 + swz / 64; C = (st & 1) * 32 + (swz % 64) / 2; }
__host__ __device__ __forceinline__ int perm32(int rho) { const int n = rho >> 4, i = rho & 15; return 8 * (i >> 2) + 4 * n + (i & 3); }

struct Unit { int pm, pn; };
typedef int i32x8 __attribute__((ext_vector_type(8)));
struct Gemm { const bf16_t* A; const bf16_t* Bt; int M, N, K; int sa, sb; };

struct StaticOrder {
    int nM, nN, nwg, G, c;
    __host__ __device__ void init(int M, int N, int G_, int c_) { nM = M / BM; nN = N / BM; nwg = nM * nN; G = G_; c = c_; }
    __host__ __device__ bool next(int i, Unit& u) const { const int L = i * G + c; if (L >= nwg) return false; map(L, u); return true; }
    __host__ __device__ void map(int L, Unit& u) const {
        int wgid = L; { const int q = nwg / NXCD, r = nwg % NXCD, xcd = wgid % NXCD, off = wgid / NXCD; wgid = (xcd < r ? xcd * (q + 1) : r * (q + 1) + (xcd - r) * q) + off; }
        const int nig = WGM * nN, gid = wgid / nig, fm = gid * WGM, gsz = (nM - fm) < WGM ? (nM - fm) : WGM;
        u.pm = fm + ((wgid % nig) % gsz); u.pn = (wgid % nig) / gsz;
    }
    __device__ __forceinline__ size_t b_off(const Unit& u, size_t tstep) const { return (size_t)u.pn * tstep; }
    __device__ __forceinline__ void a_ready(const Unit&) const {}
    __device__ __forceinline__ void done(const Unit&) const {}
};

struct MoeOrder : StaticOrder {
    const int* tile_e; size_t estride;
    __device__ __forceinline__ size_t b_off(const Unit& u, size_t tstep) const { return (size_t)tile_e[u.pm] * estride + (size_t)u.pn * tstep; }
};
struct MoeGuOrder : MoeOrder {
    int gH, NL, H; unsigned* cnt; mutable int pend; bool lead;
    __device__ bool next(int i, Unit& u) const {
        int L; if (i < gH) L = i * G + c; else { if (c < H) return false; L = gH * G + (i - gH) * NL + (c - H); }
        if (L >= nwg) return false;
        const int ug = 8 * nN, g = L / ug, idx = L - g * ug, gsz = (nM - 8 * g) < 8 ? (nM - 8 * g) : 8, x = idx & 7, j = idx >> 3;
        u.pm = 8 * g + j % gsz; u.pn = x * (nN / 8) + j / gsz; return true; }
    __device__ __forceinline__ void done(const Unit& u) const { if (pend >= 0 && lead) __hip_atomic_fetch_add(cnt + 64 * pend, 1u, __ATOMIC_RELAXED, __HIP_MEMORY_SCOPE_AGENT); pend = u.pm; }
    __device__ __forceinline__ void flush() const { if (pend >= 0 && lead) __hip_atomic_fetch_add(cnt + 64 * pend, 1u, __ATOMIC_RELAXED, __HIP_MEMORY_SCOPE_AGENT); pend = -1; }
};
struct MoeDnOrder : MoeOrder {
    const unsigned* cnt; unsigned need;
    __device__ bool next(int i, Unit& u) const {
        const int L = i * G + c; if (L >= nwg) return false;
        const int ub = 32 * nN, band = L / ub, idx = L - band * ub, rows = (nM - 32 * band) < 32 ? (nM - 32 * band) : 32;
        if (rows == 32) { const int x = idx & 7, k = idx >> 3; u.pm = 32 * band + 8 * (x >> 1) + (k & 7); u.pn = (nN / 2) * (x & 1) + (k >> 3); }
        else { u.pm = 32 * band + idx / nN; u.pn = idx % nN; }
        return true; }
    __device__ __forceinline__ void a_ready(const Unit& u) const {
        unsigned* p = (unsigned*)cnt + 64 * u.pm; unsigned sp = 0;
        while ((unsigned)__builtin_amdgcn_readfirstlane((int)__hip_atomic_load(p, __ATOMIC_RELAXED, __HIP_MEMORY_SCOPE_AGENT)) < need) { __builtin_amdgcn_s_sleep(1); if (++sp > (1u << 21)) break; }
        __builtin_amdgcn_fence(__ATOMIC_ACQUIRE, "agent"); }
};
typedef float f32x2_ __attribute__((ext_vector_type(2))); typedef __bf16 bf16x2_ __attribute__((ext_vector_type(2)));
__device__ __forceinline__ unsigned cvt_pk_bf16(float lo, float hi) { const f32x2_ v = {lo, hi}; return __builtin_bit_cast(unsigned, __builtin_convertvector(v, bf16x2_)); }
struct EpiBf16Plain {
    static constexpr bool PERM = true, AFTER_DRAIN = false;
    bf16_t* O; int ldc;
    __device__ __forceinline__ void operator()(const f32x4 (&acc)[2][2][4][2], const Unit& u, int wr, int wc, int fr, int fq) const {
        const int row0 = u.pm * BM + wr * 64 + fr, col0 = u.pn * BM + wc * 32 + 8 * fq;
#pragma unroll
        for (int ai = 0; ai < 2; ++ai)
#pragma unroll
            for (int m = 0; m < 4; ++m) { bf16_t* rowp = O + (size_t)(row0 + ai * HALF + m * 16) * ldc + col0;
#pragma unroll
                for (int bj = 0; bj < 2; ++bj) { const f32x4 v0 = acc[ai][bj][m][0], v1 = acc[ai][bj][m][1];
                    u32x4 w; w.x = cvt_pk_bf16(v0[0], v0[1]); w.y = cvt_pk_bf16(v0[2], v0[3]); w.z = cvt_pk_bf16(v1[0], v1[1]); w.w = cvt_pk_bf16(v1[2], v1[3]);
                    *(u32x4*)(rowp + bj * HALF) = w; } }
    }
};
template <bool OUT8, bool WT = false  , bool RS = false  > struct EpiSwiGLU {
    static constexpr bool PERM = true, AFTER_DRAIN = false;
    unsigned char* O; int ldc; float oscale; const PG8_LAS float* rs;
    __device__ __forceinline__ void operator()(const f32x4 (&acc)[2][2][4][2], const Unit& u, int wr, int wc, int fr, int fq) const {
        const int row0 = u.pm * BM + wr * 64 + fr, col0 = u.pn * HALF + wc * 32 + 8 * fq;
        if constexpr (WT) {
            static_assert(OUT8, "write-through variant is fp8 only");
            const bool odd = fq & 1;
#pragma unroll
            for (int ai = 0; ai < 2; ++ai)
#pragma unroll
                for (int mp = 0; mp < 4; mp += 2) { unsigned w[2][2];
#pragma unroll
                    for (int mm = 0; mm < 2; ++mm) { float r[8];
#pragma unroll
                        for (int n = 0; n < 2; ++n)
#pragma unroll
                            for (int j = 0; j < 4; ++j) { const float g = acc[ai][0][mp + mm][n][j], up = acc[ai][1][mp + mm][n][j];
                                r[n * 4 + j] = __builtin_amdgcn_fmed3f(g * __builtin_amdgcn_rcpf(1.0f + __expf(-g)) * (up * oscale), -448.0f, 448.0f); }
                        unsigned w0 = 0u, w1 = 0u;
                        w0 = __builtin_amdgcn_cvt_pk_fp8_f32(r[0], r[1], w0, false); w0 = __builtin_amdgcn_cvt_pk_fp8_f32(r[2], r[3], w0, true);
                        w1 = __builtin_amdgcn_cvt_pk_fp8_f32(r[4], r[5], w1, false); w1 = __builtin_amdgcn_cvt_pk_fp8_f32(r[6], r[7], w1, true);
                        w[mm][0] = w0; w[mm][1] = w1; }
                    const unsigned sx = odd ? w[0][0] : w[1][0], sy = odd ? w[0][1] : w[1][1];
                    const unsigned rx = (unsigned)__builtin_amdgcn_ds_swizzle((int)sx, (16 << 10) | 0x1F), ry = (unsigned)__builtin_amdgcn_ds_swizzle((int)sy, (16 << 10) | 0x1F);
                    u32x4 o; o.x = odd ? rx : w[0][0]; o.y = odd ? ry : w[0][1]; o.z = odd ? w[1][0] : rx; o.w = odd ? w[1][1] : ry;
                    unsigned char* p = O + (size_t)(row0 + ai * HALF + (mp + (odd ? 1 : 0)) * 16) * ldc + (col0 - (odd ? 8 : 0));
                    asm volatile("global_store_dwordx4 %0, %1, off sc1\n\ts_nop 1" :: "v"(p), "v"(o) : "memory"); }
            return; }
#pragma unroll
        for (int ai = 0; ai < 2; ++ai)
#pragma unroll
            for (int m = 0; m < 4; ++m) { unsigned char* rowp = O + ((size_t)(row0 + ai * HALF + m * 16) * ldc + col0) * (OUT8 ? 1 : 2);
                float r[8]; float rr = 1.0f; if constexpr (RS) rr = rs[(row0 + ai * HALF + m * 16) & 2047];
#pragma unroll
                for (int n = 0; n < 2; ++n)
#pragma unroll
                    for (int j = 0; j < 4; ++j) { const float g = acc[ai][0][m][n][j] * rr, up = acc[ai][1][m][n][j] * rr; float t = g * __builtin_amdgcn_rcpf(1.0f + __expf(-g)) * (OUT8 ? up * oscale : up); if (OUT8) t = __builtin_amdgcn_fmed3f(t, -448.0f, 448.0f);
                        r[n * 4 + j] = t; }
                if constexpr (OUT8) { unsigned w0 = 0u, w1 = 0u;
                    w0 = __builtin_amdgcn_cvt_pk_fp8_f32(r[0], r[1], w0, false); w0 = __builtin_amdgcn_cvt_pk_fp8_f32(r[2], r[3], w0, true);
                    w1 = __builtin_amdgcn_cvt_pk_fp8_f32(r[4], r[5], w1, false); w1 = __builtin_amdgcn_cvt_pk_fp8_f32(r[6], r[7], w1, true);
                    *(unsigned long long*)rowp = (unsigned long long)w0 | ((unsigned long long)w1 << 32); }
                else { u32x4 w; w.x = cvt_pk_bf16(r[0], r[1]); w.y = cvt_pk_bf16(r[2], r[3]); w.z = cvt_pk_bf16(r[4], r[5]); w.w = cvt_pk_bf16(r[6], r[7]); *(u32x4*)rowp = w; } }
    }
};
template <int MODE, bool RF32, bool EMIT = false, bool RS = false> struct EpiRes {
    static constexpr bool PERM = true, AFTER_DRAIN = false;
    bf16_t* C; const void* R; const bf16_t* P; int ld; float* SS; PG8_LAS float* part; const PG8_LAS float* rs;
    static __device__ __forceinline__ float lo_(unsigned u) { return __builtin_bit_cast(float, u << 16); }
    static __device__ __forceinline__ float hi_(unsigned u) { return __builtin_bit_cast(float, u & 0xffff0000u); }
    __device__ __forceinline__ void operator()(const f32x4 (&acc)[2][2][4][2], const Unit& u, int wr, int wc, int fr, int fq) const {
        const int row0 = u.pm * BM + wr * 64 + fr, col0 = u.pn * BM + wc * 32 + 8 * fq;
        constexpr int MB = (MODE == 2 || RF32) ? 2 : 4;
#pragma unroll
        for (int ai = 0; ai < 2; ++ai)
#pragma unroll
            for (int m0 = 0; m0 < 4; m0 += MB) {
                u32x4 rb[MB][2], pb[MB][2]; f32x4 rf[MB][2][2];
#pragma unroll
                for (int mm = 0; mm < MB; ++mm)
#pragma unroll
                    for (int bj = 0; bj < 2; ++bj) { const size_t off = (size_t)(row0 + ai * HALF + (m0 + mm) * 16) * ld + col0 + bj * HALF;
                        if constexpr (RF32) { rf[mm][bj][0] = *(const f32x4*)((const float*)R + off); rf[mm][bj][1] = *(const f32x4*)((const float*)R + off + 4); }
                        else rb[mm][bj] = *(const u32x4*)((const bf16_t*)R + off);
                        if constexpr (MODE == 2) pb[mm][bj] = *(const u32x4*)(P + off); }
#pragma unroll
                for (int mm = 0; mm < MB; ++mm) { float ssum = 0.f; float rr = 1.0f; if constexpr (RS) rr = rs[(row0 + ai * HALF + (m0 + mm) * 16) & 2047];
#pragma unroll
                    for (int bj = 0; bj < 2; ++bj) { const size_t off = (size_t)(row0 + ai * HALF + (m0 + mm) * 16) * ld + col0 + bj * HALF;
                        f32x4 r0, r1;
                        if constexpr (RF32) { r0 = rf[mm][bj][0]; r1 = rf[mm][bj][1]; }
                        else { const u32x4 w = rb[mm][bj]; r0 = (f32x4){lo_(w.x), hi_(w.x), lo_(w.y), hi_(w.y)}; r1 = (f32x4){lo_(w.z), hi_(w.z), lo_(w.w), hi_(w.w)}; }
                        f32x4 v0 = acc[ai][bj][m0 + mm][0], v1 = acc[ai][bj][m0 + mm][1]; if constexpr (RS) { v0 = v0 * rr; v1 = v1 * rr; }
                        if constexpr (MODE == 2) { const u32x4 w = pb[mm][bj]; const f32x4 p0 = {lo_(w.x), hi_(w.x), lo_(w.y), hi_(w.y)}, p1 = {lo_(w.z), hi_(w.z), lo_(w.w), hi_(w.w)};
#pragma unroll
                            for (int j = 0; j < 4; ++j) { v0[j] = p0[j] * __builtin_amdgcn_rcpf(1.0f + __expf(-v0[j])); v1[j] = p1[j] * __builtin_amdgcn_rcpf(1.0f + __expf(-v1[j])); } }
                        v0 = v0 + r0; v1 = v1 + r1;
                        u32x4 o; o.x = cvt_pk_bf16(v0[0], v0[1]); o.y = cvt_pk_bf16(v0[2], v0[3]); o.z = cvt_pk_bf16(v1[0], v1[1]); o.w = cvt_pk_bf16(v1[2], v1[3]);
                        *(u32x4*)(C + off) = o;
                        if constexpr (EMIT) { const float a0 = lo_(o.x), a1 = hi_(o.x), a2 = lo_(o.y), a3 = hi_(o.y), a4 = lo_(o.z), a5 = hi_(o.z), a6 = lo_(o.w), a7 = hi_(o.w);
                            ssum += ((a0 * a0 + a1 * a1) + (a2 * a2 + a3 * a3)) + ((a4 * a4 + a5 * a5) + (a6 * a6 + a7 * a7)); } }
                    if constexpr (EMIT) {
                        ssum += __builtin_bit_cast(float, __builtin_amdgcn_ds_swizzle(__builtin_bit_cast(int, ssum), (16 << 10) | 0x1F)); ssum += __shfl_xor(ssum, 32);
                        if (fq == 0) part[(ai * HALF + wr * 64 + (m0 + mm) * 16 + fr) * 4 + wc] = ssum; } }
                asm volatile("" ::: "memory"); }
        if constexpr (EMIT) {
            asm volatile("s_waitcnt lgkmcnt(0)\n\ts_barrier" ::: "memory");
            const int t = (wr * 4 + wc) * 64 + fq * 16 + fr;
            if (t < BM) { const f32x4 pz = *(const PG8_LAS f32x4*)(part + t * 4); SS[(size_t)(u.pm * BM + t) * 8 + u.pn] = (pz[0] + pz[1]) + (pz[2] + pz[3]); } }
    }
};
template <int MODE  > struct EpiF32 {
    static constexpr bool PERM = false, AFTER_DRAIN = false;
    float* C; const float* R; const float* P; int ldc, ldr, ldp;
    __device__ __forceinline__ void operator()(const f32x4 (&acc)[2][2][4][2], const Unit& u, int wr, int wc, int fr, int fq) const {
        const int row0 = u.pm * BM + wr * 64 + fr, col0 = u.pn * BM + wc * 32 + 4 * fq;
        constexpr int MB = (MODE == 2) ? 2 : 4;
#pragma unroll
        for (int ai = 0; ai < 2; ++ai)
#pragma unroll
            for (int m0 = 0; m0 < 4; m0 += MB) {
                f32x4 rv[MB][4], pv[MB][4];
                if (MODE >= 1) {
#pragma unroll
                    for (int mm = 0; mm < MB; ++mm) { const size_t rr = (size_t)(row0 + ai * HALF + (m0 + mm) * 16) * ldr + col0, rp = (size_t)(row0 + ai * HALF + (m0 + mm) * 16) * ldp + col0;
#pragma unroll
                        for (int q = 0; q < 4; ++q) { rv[mm][q] = *(const f32x4*)(R + rr + (q >> 1) * HALF + (q & 1) * 16); if (MODE == 2) pv[mm][q] = *(const f32x4*)(P + rp + (q >> 1) * HALF + (q & 1) * 16); } } }
#pragma unroll
                for (int mm = 0; mm < MB; ++mm) { const int m = m0 + mm; const size_t ro = (size_t)(row0 + ai * HALF + m * 16) * ldc + col0;
#pragma unroll
                    for (int q = 0; q < 4; ++q) { f32x4 v = acc[ai][q >> 1][m][q & 1];
                        if (MODE == 1) v = v + rv[mm][q];
                        if (MODE == 2) { f32x4 s;
#pragma unroll
                            for (int j = 0; j < 4; ++j) s[j] = pv[mm][q][j] * __builtin_amdgcn_rcpf(1.0f + __expf(-v[j]));
                            v = rv[mm][q] + s; }
                        *(f32x4*)(C + ro + (q >> 1) * HALF + (q & 1) * 16) = v; } }
                asm volatile("" ::: "memory"); }
    }
};


template <class Epi, class Sched, bool ALIGN_EPI = false, bool SP2 = false, bool F8 = false  >
__device__ __forceinline__ void gemm_phase(PG8_LAS unsigned char* lds, const Gemm g, const Sched& S, const Epi& E, const int wid_  ) {
    int tid = __builtin_amdgcn_mbcnt_hi(~0u, __builtin_amdgcn_mbcnt_lo(~0u, 0u)); asm volatile("" : "+v"(tid)); tid += wid_ * 64;
    const int wid = __builtin_amdgcn_readfirstlane(tid >> 6), lane = tid & 63, wr = wid >> 2, wc = wid & 3, fr = lane & 15, fq = lane >> 4;
    const int K = g.K, nt = K / BK;
    unsigned voffA[2], voffB[2];
#pragma unroll
    for (int i = 0; i < 2; ++i) { int R, C; stage_rc(tid * 16 + i * 8192, R, C); const int Rb = Epi::PERM ? ((R & ~31) + perm32(R & 31)) : R;
        voffA[i] = (unsigned)(R * K + C) * 2u; voffB[i] = (unsigned)(Rb * K + C) * 2u; }
    const unsigned kstep = (unsigned)(BK * 2);
    const unsigned hstep = (unsigned)HALF * (unsigned)K * 2u;
    const unsigned tstep = 2u * hstep;
    const unsigned ldsw = (unsigned)wid * 1024u;
    const int aoff = lds_byte(wr * 64 + fr, fq * 8), boff = lds_byte(wc * 32 + fr, fq * 8);
#define PG8_SA(b, h) (((b) * 2 + (h)) * HTB)
#define PG8_SB(b, h) ((4 + (b) * 2 + (h)) * HTB)
    const __amdgpu_buffer_rsrc_t rsrc_voffA = __builtin_amdgcn_make_buffer_rsrc((void*)g.A, 0, 0xFFFFFFFF, 0x00020000), rsrc_voffB = __builtin_amdgcn_make_buffer_rsrc((void*)g.Bt, 0, 0xFFFFFFFF, 0x00020000);
#define PG8_STAGE(bufoff, goff, voff) do { _Pragma("unroll") for (int _i = 0; _i < 2; ++_i) \
        __builtin_amdgcn_raw_ptr_buffer_load_lds(rsrc_##voff, (PG8_LAS unsigned*)(lds + (bufoff) + ldsw + _i * 8192), 16, (int)(voff)[_i], (int)(goff), 0, 0); } while (0)
#define PG8_LDA(dst, b, h) do { _Pragma("unroll") for (int m = 0; m < 4; ++m) _Pragma("unroll") for (int k = 0; k < 2; ++k) dst[m][k] = *(const PG8_LAS bf16x8*)(lds + PG8_SA(b, h) + aoff + m * 2048 + k * 1024); } while (0)
#define PG8_LDB(dst, b, h) do { _Pragma("unroll") for (int n = 0; n < 2; ++n) _Pragma("unroll") for (int k = 0; k < 2; ++k) dst[n][k] = *(const PG8_LAS bf16x8*)(lds + PG8_SB(b, h) + boff + n * 2048 + k * 1024); } while (0)
#define PG8_MMA(ai, bj, At, Bt) do { __builtin_amdgcn_s_setprio(1); _Pragma("unroll") for (int m = 0; m < 4; ++m) _Pragma("unroll") for (int n = 0; n < 2; ++n) { \
        if constexpr (F8) { const i32x8 a8_ = __builtin_bit_cast(i32x8, __builtin_shufflevector(At[m][0], At[m][1], 0, 1, 2, 3, 4, 5, 6, 7, 8, 9, 10, 11, 12, 13, 14, 15)); \
            const i32x8 b8_ = __builtin_bit_cast(i32x8, __builtin_shufflevector(Bt[n][0], Bt[n][1], 0, 1, 2, 3, 4, 5, 6, 7, 8, 9, 10, 11, 12, 13, 14, 15)); \
            acc[ai][bj][m][n] = __builtin_amdgcn_mfma_scale_f32_16x16x128_f8f6f4(b8_, a8_, acc[ai][bj][m][n], 0, 0, 0, g.sb, 0, g.sa); } \
        else { _Pragma("unroll") for (int k = 0; k < 2; ++k) acc[ai][bj][m][n] = __builtin_amdgcn_mfma_f32_16x16x32_bf16(Bt[n][k], At[m][k], acc[ai][bj][m][n], 0, 0, 0); } } \
        __builtin_amdgcn_s_setprio(0); } while (0)
#define PG8_WAIT_V(n) asm volatile("s_waitcnt vmcnt(" #n ")" ::: "memory")
#define PG8_WAIT_L(n) asm volatile("s_waitcnt lgkmcnt(" #n ")" ::: "memory")
#define PG8_BAR __builtin_amdgcn_s_barrier()
#define PG8_SCHED __builtin_amdgcn_sched_barrier(0)
    Unit cur, nxt; int ui = 0;
    if (!S.next(0, cur)) return;
    f32x4 acc[2][2][4][2];
#pragma unroll
    for (int a = 0; a < 2; ++a)
#pragma unroll
        for (int b = 0; b < 2; ++b)
#pragma unroll
            for (int m = 0; m < 4; ++m)
#pragma unroll
                for (int n = 0; n < 2; ++n) acc[a][b][m][n] = (f32x4){0.f, 0.f, 0.f, 0.f};
    bf16x8 At[4][2], B0[2][2], B1[2][2];
    unsigned cA = (unsigned)cur.pm * tstep, cB = (unsigned)S.b_off(cur, tstep);
    S.a_ready(cur);
    if constexpr (SP2) {
        PG8_STAGE(PG8_SB(0, 0), cB, voffB); PG8_STAGE(PG8_SB(0, 1), cB + hstep, voffB); PG8_STAGE(PG8_SA(0, 0), cA, voffA); PG8_STAGE(PG8_SA(0, 1), cA + hstep, voffA);
        if (wr == 1) PG8_BAR;
        PG8_WAIT_V(2); PG8_BAR;
        PG8_STAGE(PG8_SB(1, 0), cB + kstep, voffB); PG8_STAGE(PG8_SA(1, 0), cA + kstep, voffA); PG8_STAGE(PG8_SB(1, 1), cB + hstep + kstep, voffB);
        PG8_WAIT_V(6); PG8_BAR;
    } else {
        PG8_STAGE(PG8_SB(0, 0), cB, voffB); PG8_STAGE(PG8_SA(0, 0), cA, voffA); PG8_STAGE(PG8_SB(0, 1), cB + hstep, voffB); PG8_STAGE(PG8_SA(0, 1), cA + hstep, voffA);
        if (wr == 1) PG8_BAR;
        PG8_WAIT_V(4); PG8_BAR;
        PG8_STAGE(PG8_SB(1, 0), cB + kstep, voffB); PG8_STAGE(PG8_SA(1, 0), cA + kstep, voffA); PG8_STAGE(PG8_SB(1, 1), cB + hstep + kstep, voffB);
        PG8_WAIT_V(6); PG8_BAR;
    }
    for (;;) {
        const bool has_next = S.next(ui + 1, nxt);
        const unsigned nA = has_next ? (unsigned)nxt.pm * tstep : cA, nB = has_next ? (unsigned)S.b_off(nxt, tstep) : cB;
        for (int t = 0; t < nt; t += 2) {
            const bool last = (t == nt - 2);
            const unsigned a1 = cA + (unsigned)(t + 1) * kstep;
            const unsigned a2 = last ? nA : cA + (unsigned)(t + 2) * kstep, b2 = last ? nB : cB + (unsigned)(t + 2) * kstep;
            const unsigned a3 = a2 + kstep, b3 = b2 + kstep;
            if (last && has_next) S.a_ready(nxt);
            if constexpr (SP2) {
            PG8_LDB(B0, 0, 0); PG8_LDB(B1, 0, 1); PG8_SCHED; PG8_LDA(At, 0, 0); PG8_STAGE(PG8_SA(1, 1), a1 + hstep, voffA);
            PG8_WAIT_V(8); PG8_WAIT_L(0); PG8_BAR; PG8_MMA(0, 0, At, B0); PG8_MMA(0, 1, At, B1); PG8_BAR; PG8_SCHED;
            PG8_LDA(At, 0, 1); PG8_STAGE(PG8_SB(0, 0), b2, voffB); PG8_STAGE(PG8_SB(0, 1), b2 + hstep, voffB); PG8_STAGE(PG8_SA(0, 0), a2, voffA);
            PG8_WAIT_V(8); PG8_WAIT_L(0); PG8_BAR; PG8_MMA(1, 0, At, B0); PG8_MMA(1, 1, At, B1); PG8_BAR; PG8_SCHED;
            PG8_LDB(B0, 1, 0); PG8_LDB(B1, 1, 1); PG8_SCHED; PG8_LDA(At, 1, 0); PG8_STAGE(PG8_SA(0, 1), a2 + hstep, voffA);
            PG8_WAIT_V(8); PG8_WAIT_L(0); PG8_BAR; PG8_MMA(0, 0, At, B0); PG8_MMA(0, 1, At, B1); PG8_BAR; PG8_SCHED;
            PG8_LDA(At, 1, 1); PG8_STAGE(PG8_SB(1, 0), b3, voffB); PG8_STAGE(PG8_SB(1, 1), b3 + hstep, voffB); PG8_STAGE(PG8_SA(1, 0), a3, voffA);
            PG8_WAIT_V(8); PG8_WAIT_L(0); PG8_BAR; PG8_MMA(1, 0, At, B0); PG8_MMA(1, 1, At, B1); PG8_BAR; PG8_SCHED;
            } else {
            PG8_LDB(B0, 0, 0); PG8_SCHED; PG8_LDA(At, 0, 0); PG8_STAGE(PG8_SA(1, 1), a1 + hstep, voffA);
            PG8_WAIT_L(8); PG8_BAR; PG8_WAIT_L(0); PG8_MMA(0, 0, At, B0); PG8_BAR; PG8_SCHED;
            PG8_LDB(B1, 0, 1); PG8_STAGE(PG8_SB(0, 0), b2, voffB);
            PG8_BAR; PG8_WAIT_L(0); PG8_MMA(0, 1, At, B1); PG8_BAR;
            PG8_LDA(At, 0, 1); PG8_STAGE(PG8_SA(0, 0), a2, voffA);
            PG8_BAR; PG8_WAIT_L(0); PG8_MMA(1, 0, At, B0); PG8_BAR; PG8_SCHED;
            PG8_STAGE(PG8_SB(0, 1), b2 + hstep, voffB);
            PG8_WAIT_V(6); PG8_BAR; PG8_MMA(1, 1, At, B1); PG8_BAR;
            PG8_LDB(B0, 1, 0); PG8_SCHED; PG8_LDA(At, 1, 0); PG8_STAGE(PG8_SA(0, 1), a2 + hstep, voffA);
            PG8_WAIT_L(8); PG8_BAR; PG8_WAIT_L(0); PG8_MMA(0, 0, At, B0); PG8_BAR; PG8_SCHED;
            PG8_LDB(B1, 1, 1); PG8_STAGE(PG8_SB(1, 0), b3, voffB);
            PG8_BAR; PG8_WAIT_L(0); PG8_MMA(0, 1, At, B1); PG8_BAR;
            PG8_LDA(At, 1, 1); PG8_STAGE(PG8_SA(1, 0), a3, voffA);
            PG8_BAR; PG8_WAIT_L(0); PG8_MMA(1, 0, At, B0); PG8_BAR; PG8_SCHED;
            PG8_STAGE(PG8_SB(1, 1), b3 + hstep, voffB);
            PG8_WAIT_V(6); PG8_BAR; PG8_MMA(1, 1, At, B1); PG8_BAR;
            }
        }
        if constexpr (ALIGN_EPI) { if (wr == 0) PG8_BAR; }
        if constexpr (!Epi::AFTER_DRAIN) { int le_ = __builtin_amdgcn_mbcnt_hi(~0u, __builtin_amdgcn_mbcnt_lo(~0u, 0u)); asm volatile("" : "+v"(le_));
            E(acc, cur, wr, wc, le_ & 15, le_ >> 4); S.done(cur); }
        if (!has_next) break;
#pragma unroll
        for (int a = 0; a < 2; ++a)
#pragma unroll
            for (int b = 0; b < 2; ++b)
#pragma unroll
                for (int m = 0; m < 4; ++m)
#pragma unroll
                    for (int n = 0; n < 2; ++n) acc[a][b][m][n] = (f32x4){0.f, 0.f, 0.f, 0.f};
        cur = nxt; cA = nA; cB = nB; ++ui;
        if constexpr (ALIGN_EPI) { if (wr == 1) PG8_BAR; }
    }
    PG8_WAIT_V(0);
    if constexpr (!ALIGN_EPI) { if (wr == 0) PG8_BAR; }
    PG8_BAR;
    if constexpr (Epi::AFTER_DRAIN) { E.fused(acc, cur, wr, wc, fr, fq, lds, wid, lane); S.done(cur); }
#undef PG8_SA
#undef PG8_SB
#undef PG8_STAGE
#undef PG8_LDA
#undef PG8_LDB
#undef PG8_MMA
#undef PG8_WAIT_V
#undef PG8_WAIT_L
#undef PG8_BAR
#undef PG8_SCHED
}
}
#define XB_TMO      128
#define XB_XCNT(j)  (256  + 64 * (j))
#define XB_XSUB(j)  (1280 + 64 * (j))
#define XB_XGEN(j)  (2304 + 64 * (j))
#define XB_TOP      3328
#define XB_TOPGEN   3392
#define XCD_BAR_WORDS 3456
#define XB_SPIN_CAP (1u << 18)

__device__ __forceinline__ unsigned xb_ld(unsigned* p)              { return __hip_atomic_load(p, __ATOMIC_RELAXED, __HIP_MEMORY_SCOPE_AGENT); }
__device__ __forceinline__ unsigned xb_add(unsigned* p, unsigned v) { return __hip_atomic_fetch_add(p, v, __ATOMIC_RELAXED, __HIP_MEMORY_SCOPE_AGENT); }
__device__ __forceinline__ unsigned xb_xcc_id() { return (unsigned)__builtin_amdgcn_s_getreg((3 << 11) | 20) & 0xFu; }
#define XB_SPIN(cond, bar) do { unsigned _sp = 0; while (cond) { __builtin_amdgcn_s_sleep(1); \
    if ((++_sp & 255u) == 0u) { if (xb_ld(&(bar)[XB_TMO])) break; if (_sp > XB_SPIN_CAP) { atomicAdd(&(bar)[XB_TMO], 1u); break; } } } } while (0)

struct XcdBarrier {
    unsigned* bar; unsigned x;
    volatile LAS unsigned* st;
};

__device__ __forceinline__ XcdBarrier xcd_barrier_post(unsigned* bar, volatile LAS unsigned* st) {
    XcdBarrier b; b.bar = bar; b.x = xb_xcc_id(); b.st = st;
    if (threadIdx.x == 0) (void)xb_add(&bar[XB_XCNT(b.x)], 1u);
    return b;
}
__device__ __forceinline__ void xcd_barrier_complete(unsigned* bar, unsigned x, unsigned& nloc, unsigned& nx) {
    const unsigned G = gridDim.x * gridDim.y * gridDim.z;
    unsigned sum, cnt, mine, sp = 0u;
    for (;;) {
        sum = 0u; cnt = 0u; mine = 0u;
#pragma unroll
        for (unsigned j = 0; j < 16; ++j) { const unsigned c = xb_ld(&bar[XB_XCNT(j)]); sum += c; cnt += (c > 0u) ? 1u : 0u; mine = (j == x) ? c : mine; }
        if (sum == G) break;
        __builtin_amdgcn_s_sleep(1);
        if ((++sp & 255u) == 0u) { if (xb_ld(&bar[XB_TMO])) break; if (sp > XB_SPIN_CAP) { atomicAdd(&bar[XB_TMO], 1u); break; } }
    }
    nloc = mine > 0u ? mine : 1u; nx = cnt > 0u ? cnt : 1u;
}

__device__ __forceinline__ void xcd_barrier(const XcdBarrier& b) {
    asm volatile("s_waitcnt vmcnt(0)" ::: "memory");
    __syncthreads();
    if (threadIdx.x == 0) {
        unsigned* bar = b.bar;
        __builtin_amdgcn_s_waitcnt(0);
        unsigned nloc = b.st[0], nx = b.st[1];
        if (nloc == 0u) { xcd_barrier_complete(bar, b.x, nloc, nx); b.st[0] = nloc; b.st[1] = nx; }
        const unsigned old = xb_add(&bar[XB_XSUB(b.x)], 1u);
        const unsigned gen = old / nloc;
        if (old + 1u == (gen + 1u) * nloc) {
            __builtin_amdgcn_fence(__ATOMIC_RELEASE, "agent");
            asm volatile("s_waitcnt vmcnt(0)" ::: "memory");
            const unsigned og = xb_add(&bar[XB_TOP], 1u);
            const unsigned tg = og / nx;
            if (og + 1u == (tg + 1u) * nx) xb_add(&bar[XB_TOPGEN], 1u);
            else XB_SPIN(xb_ld(&bar[XB_TOPGEN]) == tg, bar);
            __builtin_amdgcn_fence(__ATOMIC_ACQUIRE, "agent");
            xb_add(&bar[XB_XGEN(b.x)], 1u);
            asm volatile("s_waitcnt vmcnt(0)" ::: "memory");
        } else {
            XB_SPIN(xb_ld(&bar[XB_XGEN(b.x)]) == gen, bar);
            __builtin_amdgcn_fence(__ATOMIC_ACQUIRE, "agent");
            asm volatile("s_waitcnt vmcnt(0)" ::: "memory");
        }
    }
    __syncthreads();
}

constexpr int NWAVES = 8, NTHR = 512, GRID = 256;
constexpr int M = 16384, D = 2048, SEQ = 2048, NBATCH = 8, NZ = 7168, NIN = 7184, DFF = 7168, NEXP = 8, PLE = 256;
constexpr int NCHUNK = 1024;
constexpr int NCONV = 118;
constexpr float EPS = 1e-6f;
constexpr int LS_HN = 2, LS_WGU = 5, LS_ACT = 3, LS_WD = 6;
constexpr int SB(int l) { return (127 - l) * 0x01010101; }
constexpr int MAXPT = 136;
constexpr size_t MiB = 1u << 20;
constexpr size_t WS_CTL = 0, CTL_ZERO_BYTES = 1 * MiB;
constexpr size_t WS_WGT = 1 * MiB;
constexpr size_t WS_WRT = WS_WGT + 256 * 1024;
constexpr size_t WS_GD = 2 * MiB, WS_MLS = 3 * MiB, WS_MLCS = 5 * MiB  , WS_DNGL = 5 * MiB + 16384;
constexpr size_t WS_TOPE = 6 * MiB, WS_TOPW = WS_TOPE + 128 * 1024, WS_SLOT = WS_TOPW + 128 * 1024, WS_BLKCNT = WS_SLOT + 128 * 1024, WS_TILEE = WS_BLKCNT + 64 * 1024;
constexpr size_t WS_WIN = 8 * MiB, WS_WOUT = 64 * MiB, WS_WGU = 80 * MiB, WS_WD = 136 * MiB, WS_WPG = 164 * MiB, WS_WPP = 180 * MiB, WS_MGU = 182 * MiB, WS_MD = 630 * MiB;
constexpr size_t WS_H = 854 * MiB, WS_HN = 982 * MiB, WS_T = 1046 * MiB, WS_END = (1046 + 748) * MiB;
constexpr size_t T_Z = 0, T_ZC = 224 * MiB, T_U = 304 * MiB, T_W = 336 * MiB, T_QG = 368 * MiB, T_KGT = 384 * MiB, T_ATT = 400 * MiB, T_DCT = 408 * MiB, T_CST = 474 * MiB, T_MIX = 510 * MiB;
constexpr size_t T_ACT = 0, T_APERM = 476 * MiB, T_YPERM = 612 * MiB, T_PB = 0, T_PP = 16 * MiB;
constexpr size_t T_PB0 = 576 * MiB, T_SS = 584 * MiB;
constexpr int CW_TMO = 0;
constexpr int CW_QUEUE = 2048;
constexpr int CW_MOECNT = 16384;
constexpr int CW_BAR = 4096;
constexpr int RING_BYTES = 131072;
constexpr int MISC_OFF = 139264;
constexpr int LDS_RSTD = 147456;
constexpr int LDS_BYTES = 155648;


struct Params { const float* in[30]; float* out; unsigned char* ws; int ph_lo, ph_hi; };
enum { I_X = 0, I_P, I_ATTN_NORM, I_W_IN, I_CONV_DN, I_CONV_ML, I_DN_A_LOG, I_DN_DT_BIAS, I_DN_NORM, I_LQ1, I_LK1, I_LQ2, I_LK2, I_DIFF_NORM, I_ML_I_BIAS, I_ML_F_BIAS, I_ML_NORM,
       I_W_OUT, I_FFN_NORM, I_DG, I_DU, I_DD, I_ROUTER, I_MG, I_MU, I_MD, I_PLE_NORM, I_PLE_PROJ, I_PLE_GATE, I_FINAL_NORM };
struct Frame { LAS unsigned char* lds; volatile LAS unsigned* MISC; int tid, lane, wave, G, bid; };

DI float wave_incl_sum(float v, int lane) {
#pragma unroll
    for (int o = 1; o < 64; o <<= 1) { const float t = __shfl_up(v, o); if (lane >= o) v += t; }
    return v;
}
DI float wave_incl_max(float v, int lane) {
#pragma unroll
    for (int o = 1; o < 64; o <<= 1) { const float t = __shfl_up(v, o); if (lane >= o) v = fmaxf(v, t); }
    return v;
}
DI bf16x8 frag_row(const LAS unsigned char* base, int RS, int r0, int k0, int lane) { return *(const LAS bf16x8*)(base + (r0 + (lane & 15)) * RS + (k0 + 8 * (lane >> 4)) * 2); }
DI bf16x8 frag_tr2(unsigned base_addr, int RS, int rowA, int rowB, int c0, int lane) {
    const int q = (lane & 15) >> 2, p = lane & 3;
    const unsigned a0 = base_addr + (unsigned)((rowA + q) * RS + (c0 + 4 * p) * 2), a1 = base_addr + (unsigned)((rowB + q) * RS + (c0 + 4 * p) * 2);
    s16x4 x, y;
    asm volatile("ds_read_b64_tr_b16 %0, %2\n\tds_read_b64_tr_b16 %1, %3\n\ts_waitcnt lgkmcnt(0)" : "=&v"(x), "=&v"(y) : "v"(a0), "v"(a1) : "memory");
    bf16x8 r; r[0] = x[0]; r[1] = x[1]; r[2] = x[2]; r[3] = x[3]; r[4] = y[0]; r[5] = y[1]; r[6] = y[2]; r[7] = y[3]; return r;
}
DI bf16x8 frag_tr(unsigned base_addr, int RS, int k0, int c0, int lane) { const int g = lane >> 4; return frag_tr2(base_addr, RS, k0 + 8 * g, k0 + 8 * g + 4, c0, lane); }
#define MFMA16(a, b, c) __builtin_amdgcn_mfma_f32_16x16x32_bf16((a), (b), (c), 0, 0, 0)

template <bool F8> DI void tr_tile(const float* __restrict__ W, int ldn, int K, int k0, int nsrc0, unsigned char* __restrict__ WT, int ndst0, LAS unsigned char* scr, int lane, float wscale, const float* gk = nullptr  ) {
    const int r = lane >> 4, c4 = lane & 15;
    f32x4 v[16];
#pragma unroll
    for (int i = 0; i < 16; ++i) v[i] = __builtin_nontemporal_load((const f32x4*)(W + (size_t)(k0 + 4 * i + r) * ldn + nsrc0 + 4 * c4));
#pragma unroll
    for (int i = 0; i < 16; ++i) { f32x4 x = F8 ? v[i] * wscale : v[i]; if (!F8 && gk) x = x * gk[k0 + 4 * i + r];
        *(LAS unsigned long long*)(scr + (4 * i + r) * 144 + c4 * 8) = (unsigned long long)pk2(x[0], x[1]) | ((unsigned long long)pk2(x[2], x[3]) << 32); }
    LDS_WAIT();
    const int g = lane >> 4, j = lane & 15, q = j >> 2, pp = j & 3;
    if constexpr (F8) {
        const unsigned base = (unsigned)(size_t)scr + (unsigned)((16 * g + q) * 144 + pp * 8);
#pragma unroll
        for (int nb = 0; nb < 4; ++nb) {
            s16x4 l0, h0, l1, h1; const unsigned a0 = base + (unsigned)(32 * nb);
            asm volatile("ds_read_b64_tr_b16 %0, %4\n\tds_read_b64_tr_b16 %1, %4 offset:576\n\tds_read_b64_tr_b16 %2, %4 offset:1152\n\tds_read_b64_tr_b16 %3, %4 offset:1728\n\ts_waitcnt lgkmcnt(0)" : "=&v"(l0), "=&v"(h0), "=&v"(l1), "=&v"(h1) : "v"(a0) : "memory");
            const size_t n = (size_t)(ndst0 + 16 * nb + j); const int kk = k0 + 16 * g;
            u32x4 o; o.x = pk4_fp8(bf2f((bf16)l0[0]), bf2f((bf16)l0[1]), bf2f((bf16)l0[2]), bf2f((bf16)l0[3])); o.y = pk4_fp8(bf2f((bf16)h0[0]), bf2f((bf16)h0[1]), bf2f((bf16)h0[2]), bf2f((bf16)h0[3]));
            o.z = pk4_fp8(bf2f((bf16)l1[0]), bf2f((bf16)l1[1]), bf2f((bf16)l1[2]), bf2f((bf16)l1[3])); o.w = pk4_fp8(bf2f((bf16)h1[0]), bf2f((bf16)h1[1]), bf2f((bf16)h1[2]), bf2f((bf16)h1[3]));
            *(u32x4*)(WT + n * K + kk) = o; }
    } else {
        const unsigned base = (unsigned)(size_t)scr + (unsigned)((8 * g + q) * 144 + pp * 8);
#pragma unroll
        for (int nb = 0; nb < 4; ++nb)
#pragma unroll
            for (int kh = 0; kh < 2; ++kh) {
                s16x4 lo, hi; const unsigned a0 = base + (unsigned)(32 * kh * 144 + 32 * nb);
                asm volatile("ds_read_b64_tr_b16 %0, %2\n\tds_read_b64_tr_b16 %1, %2 offset:576\n\ts_waitcnt lgkmcnt(0)" : "=&v"(lo), "=&v"(hi) : "v"(a0) : "memory");
                const size_t n = (size_t)(ndst0 + 16 * nb + j); const int kk = k0 + 32 * kh + 8 * g;
                bf16x8 o; o[0] = lo[0]; o[1] = lo[1]; o[2] = lo[2]; o[3] = lo[3]; o[4] = hi[0]; o[5] = hi[1]; o[6] = hi[2]; o[7] = hi[3];
                *(bf16x8*)(WT + (n * K + kk) * 2) = o; } }
    LDS_WAIT();
}
template <int PART> DI void prologue_phase(const Params& P, const Frame& F) {
    LAS unsigned char* scr = F.lds + F.wave * 9216;
    const int gw = (PART == 0 ? F.bid : F.bid - (GRID - NCONV)) * NWAVES + F.wave, NGW = (PART == 0 ? GRID : NCONV) * NWAVES;
    constexpr int I_WIN = 32 * 112, I_WOUT = 32 * 32, I_GU = 32 * 224, I_DN = 112 * 32, I_PG = 32 * 32, I_PP = 4 * 32;
    constexpr int C0 = 2 * I_WIN, C1 = C0 + 2 * I_WOUT, C2 = C1 + I_GU, C3 = C2 + I_DN, C4 = C3 + 8 * I_GU, C5 = C4 + 8 * I_DN, C6 = C5 + 2 * I_PG, C7 = C6 + 2 * I_PP;
    unsigned char* ws = P.ws;
    for (int it = (PART == 0 ? 0 : I_WIN) + gw; it < (PART == 0 ? I_WIN : C7); it += NGW) {
        const float* src; const float* src2 = nullptr; bf16* dst; int K, ldn, ntn, r, kind = 0; const bool f8 = (it >= C1 && it < C5) || (it >= C5 + I_PG && it < C6);
        if (it < C0)      { const int l = it / I_WIN; r = it % I_WIN; src = P.in[I_W_IN] + (size_t)l * D * NIN; dst = (bf16*)(ws + WS_WIN) + (size_t)l * NZ * D; K = D; ldn = NIN; ntn = NZ / 64; kind = 1; }
        else if (it < C1) { const int q = it - C0, l = q / I_WOUT; r = q % I_WOUT; src = P.in[I_W_OUT] + (size_t)l * D * D; dst = (bf16*)(ws + WS_WOUT) + (size_t)l * D * D; K = D; ldn = D; ntn = D / 64; }
        else if (it < C2) { r = it - C1; src = P.in[I_DG]; src2 = P.in[I_DU]; dst = (bf16*)(ws + WS_WGU); K = D; ldn = DFF; ntn = 2 * DFF / 64; kind = 2; }
        else if (it < C3) { r = it - C2; src = P.in[I_DD]; dst = (bf16*)(ws + WS_WD); K = DFF; ldn = D; ntn = D / 64; }
        else if (it < C4) { const int q = it - C3, e = q / I_GU; r = q % I_GU; src = P.in[I_MG] + (size_t)e * D * DFF; src2 = P.in[I_MU] + (size_t)e * D * DFF; dst = (bf16*)(ws + WS_MGU + (size_t)e * 2 * DFF * D); K = D; ldn = DFF; ntn = 2 * DFF / 64; kind = 2; }
        else if (it < C5) { const int q = it - C4, e = q / I_DN; r = q % I_DN; src = P.in[I_MD] + (size_t)e * DFF * D; dst = (bf16*)(ws + WS_MD + (size_t)e * D * DFF); K = DFF; ldn = D; ntn = D / 64; }
        else if (it < C6) { const int q = it - C5, l = q / I_PG; r = q % I_PG; src = P.in[I_PLE_GATE] + (size_t)l * D * D; dst = (bf16*)(ws + WS_WPG) + (size_t)l * D * D; K = D; ldn = D; ntn = D / 64; }
        else              { const int q = it - C6, l = q / I_PP; r = q % I_PP; src = P.in[I_PLE_PROJ] + (size_t)l * PLE * D; dst = (bf16*)(ws + WS_WPP) + (size_t)l * D * PLE; K = PLE; ldn = D; ntn = D / 64; }
        const int kb = r / ntn, nb = r % ntn, k0 = 64 * kb, ndst0 = 64 * nb;
        int nsrc0 = ndst0;
        if (kind == 1) nsrc0 = ndst0 + (ndst0 >= 3072 ? 8 : 0);
        if (kind == 2) { const int t = nb >> 2, q = nb & 3; if (q >= 2) src = src2; nsrc0 = 128 * t + 64 * (q & 1); }
        if (f8) tr_tile<true>(src, ldn, K, k0, nsrc0, (unsigned char*)dst, ndst0, scr, F.lane, (kind == 2 || it >= C5) ? (float)(1 << LS_WGU) : (float)(1 << LS_WD));
        else tr_tile<false>(src, ldn, K, k0, nsrc0, (unsigned char*)dst, ndst0, scr, F.lane, 1.0f, (it >= C1 && it < C2) ? P.in[I_FFN_NORM] : (it >= C5 && it < C5 + I_PG) ? P.in[I_PLE_NORM] : nullptr);
    }
    if (PART == 1) {
        const f32x4* src = (const f32x4*)P.in[I_P]; unsigned long long* dst = (unsigned long long*)(ws + WS_T + T_PB0);
        for (int i = gw * 64 + F.lane; i < M * PLE / 4; i += NGW * 64) { const f32x4 pv = __builtin_nontemporal_load(src + i); dst[i] = (unsigned long long)pk2(pv[0], pv[1]) | ((unsigned long long)pk2(pv[2], pv[3]) << 32); }
        return; }
    const int gt = F.bid * NTHR + F.tid, NGT = F.G * NTHR;
    float* WGT = (float*)(ws + WS_WGT); float* WRT = (float*)(ws + WS_WRT);
    for (int e = gt; e < 2 * 16 * D; e += NGT) { const int l = e / (16 * D), j = (e / D) % 16, k = e % D; const int col = j < 8 ? 3072 + j : 7176 + (j - 8);
        WGT[e] = P.in[I_W_IN][((size_t)l * D + k) * NIN + col]; }
    for (int e = gt; e < NEXP * D; e += NGT) { const int j = e / D, k = e % D; WRT[e] = P.in[I_ROUTER][(size_t)k * NEXP + j]; }
}

DI void rstd_fill(const Params& P, const Frame& F) {
    const float* SS = (const float*)(P.ws + WS_T + T_SS); LAS float* rs = (LAS float*)(F.lds + LDS_RSTD); const int base = 2048 * (F.bid & 7);
    for (int i = F.tid; i < 2048; i += NTHR) { const f32x4 a = *(const f32x4*)(SS + (size_t)(base + i) * 8), b = *(const f32x4*)(SS + (size_t)(base + i) * 8 + 4);
        rs[i] = 1.0f / sqrtf((((a[0] + a[1]) + (a[2] + a[3])) + ((b[0] + b[1]) + (b[2] + b[3]))) * (1.0f / D) + EPS); }
    __syncthreads();
}
template <int MODE, bool SB  > DI void norm_phase(const Params& P, const Frame& F, int L, const void* src_, const float* gain, bool combine) {
    const float* src = (const float*)src_; const bf16* srcb = (const bf16*)src_;
    unsigned char* ws = P.ws;
    const int r_lo = (int)((long)F.bid * M / F.G), r_hi = (int)((long)(F.bid + 1) * M / F.G);
    bf16* HN = (bf16*)(ws + WS_HN);
    if (MODE == 1) { const f32x4* w = (const f32x4*)((const float*)(ws + WS_WGT) + (size_t)L * 16 * D); for (int i = F.tid; i < 16 * D / 4; i += NTHR) ((LAS f32x4*)F.lds)[i] = w[i]; __syncthreads(); }
    if (MODE == 2) { const f32x4* w = (const f32x4*)(ws + WS_WRT); for (int i = F.tid; i < NEXP * D / 4; i += NTHR) ((LAS f32x4*)F.lds)[i] = w[i]; if (F.tid < 8) F.MISC[16 + F.tid] = 0u; __syncthreads(); }
    f32x4 g[8];
#pragma unroll
    for (int j = 0; j < 8; ++j) g[j] = *(const f32x4*)(gain + 4 * F.lane + 256 * j);
    f32x4 vn[SB ? 1 : 8]; u32x2 vb[SB ? 8 : 1];
#pragma unroll
    for (int j = 0; j < 8; ++j) { if constexpr (SB) vb[j] = *(const u32x2*)(srcb + (size_t)(r_lo + F.wave) * D + 4 * F.lane + 256 * j); else vn[j] = *(const f32x4*)(src + (size_t)(r_lo + F.wave) * D + 4 * F.lane + 256 * j); }
#pragma unroll 1
    for (int row = r_lo + F.wave; row < r_hi; row += NWAVES) {
        f32x4 v[8];
#pragma unroll
        for (int j = 0; j < 8; ++j) { if constexpr (SB) v[j] = (f32x4){bflo(vb[j].x), bfhi(vb[j].x), bflo(vb[j].y), bfhi(vb[j].y)}; else v[j] = vn[j]; }
        { const int rnx = (row + NWAVES < r_hi) ? row + NWAVES : row;
#pragma unroll
          for (int j = 0; j < 8; ++j) { if constexpr (SB) vb[j] = *(const u32x2*)(srcb + (size_t)rnx * D + 4 * F.lane + 256 * j); else vn[j] = *(const f32x4*)(src + (size_t)rnx * D + 4 * F.lane + 256 * j); } }
        if (MODE == 3 && combine) {
            const int* SLOT = (const int*)(ws + WS_SLOT); const float* TOPW = (const float*)(ws + WS_TOPW); const bf16* Y = (const bf16*)(ws + WS_T + T_YPERM);
            const int s1 = SLOT[row * 2], s2 = SLOT[row * 2 + 1]; const float w1 = TOPW[row * 2], w2 = TOPW[row * 2 + 1];
            u32x2 ya[8], yb[8];
#pragma unroll
            for (int j = 0; j < 8; ++j) { ya[j] = *(const u32x2*)(Y + (size_t)s1 * D + 4 * F.lane + 256 * j); yb[j] = *(const u32x2*)(Y + (size_t)s2 * D + 4 * F.lane + 256 * j); }
#pragma unroll
            for (int j = 0; j < 8; ++j) { const f32x4 y1 = (f32x4){bflo(ya[j].x), bfhi(ya[j].x), bflo(ya[j].y), bfhi(ya[j].y)}, y2 = (f32x4){bflo(yb[j].x), bfhi(yb[j].x), bflo(yb[j].y), bfhi(yb[j].y)};
                v[j] = v[j] + w1 * y1 + w2 * y2;
                const u32x2 hb = {pk2(v[j][0], v[j][1]), pk2(v[j][2], v[j][3])}; *(u32x2*)(const_cast<bf16*>(srcb) + (size_t)row * D + 4 * F.lane + 256 * j) = hb;
                v[j] = (f32x4){bflo(hb.x), bfhi(hb.x), bflo(hb.y), bfhi(hb.y)}; }
        }
        float ss = 0.f;
#pragma unroll
        for (int j = 0; j < 8; ++j) ss += (v[j][0] * v[j][0] + v[j][1] * v[j][1]) + (v[j][2] * v[j][2] + v[j][3] * v[j][3]);
        const float rstd = 1.0f / sqrtf(wave_sum(ss) * (1.0f / D) + EPS);
#pragma unroll
        for (int j = 0; j < 8; ++j) v[j] = v[j] * rstd * g[j];
        if (MODE == 4) {
#pragma unroll
            for (int j = 0; j < 8; ++j) *(f32x4*)(P.out + (size_t)row * D + 4 * F.lane + 256 * j) = v[j];
        } else if (MODE == 0 || MODE == 2 || (MODE == 3 && L == 1)) {
            unsigned* o4 = (unsigned*)((unsigned char*)HN + (size_t)row * D) + F.lane; const float hs = (float)(1 << LS_HN);
#pragma unroll
            for (int j = 0; j < 8; ++j) o4[64 * j] = pk4_fp8(v[j][0] * hs, v[j][1] * hs, v[j][2] * hs, v[j][3] * hs);
        } else {
            unsigned long long* o8 = (unsigned long long*)(HN + (size_t)row * D) + F.lane;
#pragma unroll
            for (int j = 0; j < 8; ++j) o8[64 * j] = (unsigned long long)pk2(v[j][0], v[j][1]) | ((unsigned long long)pk2(v[j][2], v[j][3]) << 32);
        }
        if (MODE == 1) {
            float s[16];
#pragma unroll
            for (int q = 0; q < 16; ++q) { float t = 0.f;
#pragma unroll
                for (int j = 0; j < 8; ++j) { const f32x4 w = *(const LAS f32x4*)(F.lds + (size_t)(q * D + 256 * j + 4 * F.lane) * 4); t += (v[j][0] * w[0] + v[j][1] * w[1]) + (v[j][2] * w[2] + v[j][3] * w[3]); }
                s[q] = t; if ((q & 3) == 3) asm volatile("" ::: "memory"); }
#pragma unroll
            for (int i = 0; i < 8; ++i) { const bool hi = (F.lane & 32) != 0; const float send = hi ? s[i] : s[i + 8], keep = hi ? s[i + 8] : s[i]; s[i] = keep + shx<32>(send); }
#pragma unroll
            for (int i = 0; i < 4; ++i) { const bool hi = (F.lane & 16) != 0; const float send = hi ? s[i] : s[i + 4], keep = hi ? s[i + 4] : s[i]; s[i] = keep + shx<16>(send); }
#pragma unroll
            for (int i = 0; i < 2; ++i) { const bool hi = (F.lane & 8) != 0; const float send = hi ? s[i] : s[i + 2], keep = hi ? s[i + 2] : s[i]; s[i] = keep + shx<8>(send); }
            { const bool hi = (F.lane & 4) != 0; const float send = hi ? s[0] : s[1], keep = hi ? s[1] : s[0]; s[0] = keep + shx<4>(send); }
            float mine = s[0]; mine += shx<2>(mine); mine += shx<1>(mine);
            if ((F.lane & 3) == 0) { const int gi = ((F.lane >> 5) & 1) * 8 + ((F.lane >> 4) & 1) * 4 + ((F.lane >> 3) & 1) * 2 + ((F.lane >> 2) & 1), h = gi & 3; float r;
                if (gi < 4) r = sigmoidf_(mine);
                else if (gi < 8) r = -__expf(P.in[I_DN_A_LOG][L * 4 + h]) * softplusf_(mine + P.in[I_DN_DT_BIAS][L * 4 + h]);
                else if (gi < 12) r = mine + P.in[I_ML_I_BIAS][L * 4 + h];
                else r = -softplusf_(-(mine + P.in[I_ML_F_BIAS][L * 4 + h]));
                ((float*)(ws + WS_GD))[(size_t)row * 16 + gi] = r; }
        }
        if (MODE == 2) {
            int e1 = 0, e2 = 0; float l1 = -INFINITY, l2 = -INFINITY;
#pragma unroll 1
            for (int q = 0; q < 8; ++q) { float s = 0.f;
#pragma unroll
                for (int j = 0; j < 8; ++j) { const f32x4 w = *(const LAS f32x4*)(F.lds + (size_t)(q * D + 256 * j + 4 * F.lane) * 4); s += (v[j][0] * w[0] + v[j][1] * w[1]) + (v[j][2] * w[2] + v[j][3] * w[3]); }
                s = wave_sum(s);
                if (s > l1) { l2 = l1; e2 = e1; l1 = s; e1 = q; } else if (s > l2) { l2 = s; e2 = q; } }
            if (F.lane == 0) { const float w1 = 1.0f / (1.0f + __expf(l2 - l1));
                ((int*)(ws + WS_TOPE))[row * 2] = e1; ((int*)(ws + WS_TOPE))[row * 2 + 1] = e2; ((float*)(ws + WS_TOPW))[row * 2] = w1; ((float*)(ws + WS_TOPW))[row * 2 + 1] = 1.0f - w1;
                __hip_atomic_fetch_add((LAS unsigned*)&F.MISC[16 + e1], 1u, __ATOMIC_RELAXED, __HIP_MEMORY_SCOPE_WORKGROUP);
                __hip_atomic_fetch_add((LAS unsigned*)&F.MISC[16 + e2], 1u, __ATOMIC_RELAXED, __HIP_MEMORY_SCOPE_WORKGROUP); }
        }
        if (MODE == 3) { const f32x4 pv = *(const f32x4*)(P.in[I_P] + ((size_t)L * M + row) * PLE + 4 * F.lane);
            *((unsigned long long*)((bf16*)(ws + WS_T + T_PB) + (size_t)row * PLE) + F.lane) = (unsigned long long)pk2(pv[0], pv[1]) | ((unsigned long long)pk2(pv[2], pv[3]) << 32); }
    }
    if (MODE == 2) { __syncthreads(); if (F.tid < 8) ((int*)(ws + WS_BLKCNT))[F.bid * 8 + F.tid] = (int)F.MISC[16 + F.tid]; }
    if (MODE == 1 || MODE == 2) __syncthreads();
}

DI void moe_gather_phase(const Params& P, const Frame& F) {
    unsigned char* ws = P.ws;
    const int r_lo = (int)((long)F.bid * M / F.G), r_hi = (int)((long)(F.bid + 1) * M / F.G), nr = r_hi - r_lo;
    LAS int* tot = (LAS int*)F.lds; LAS int* pre = tot + 8; LAS int* base = tot + 16; LAS int* tope = tot + 64; LAS int* slots = tot + 64 + 1024;
    const int* BLK = (const int*)(ws + WS_BLKCNT); const int* TOPE = (const int*)(ws + WS_TOPE);
    if (F.tid < 16) tot[F.tid] = 0;
    __syncthreads();
    for (int i = F.tid; i < F.G * 8; i += NTHR) { const int v = BLK[i], c = i >> 3, e = i & 7;
        __hip_atomic_fetch_add(&tot[e], v, __ATOMIC_RELAXED, __HIP_MEMORY_SCOPE_WORKGROUP); if (c < F.bid) __hip_atomic_fetch_add(&pre[e], v, __ATOMIC_RELAXED, __HIP_MEMORY_SCOPE_WORKGROUP); }
    for (int i = F.tid; i < 2 * nr; i += NTHR) tope[i] = TOPE[r_lo * 2 + i];
    __syncthreads();
    if (F.tid == 0) {
        int off = 0; int* TILE_E = (int*)(ws + WS_TILEE);
        for (int e = 0; e < 8; ++e) { const int pad = (tot[e] + 255) & ~255; base[e] = off + pre[e];
            if (F.bid == 0) for (int t = off / 256; t < (off + pad) / 256; ++t) TILE_E[t] = e;
            off += pad; }
        if (F.bid == 0) TILE_E[255] = off / 256;
        int* SLOT = (int*)(ws + WS_SLOT);
        for (int i = 0; i < 2 * nr; ++i) { const int e = tope[i]; const int s = base[e]; base[e] = s + 1; slots[i] = s; SLOT[r_lo * 2 + i] = s; }
    }
    __syncthreads();
    const unsigned char* HN = (const unsigned char*)(ws + WS_HN); unsigned char* AP = (unsigned char*)(ws + WS_T + T_APERM);
    for (int i = F.tid >> 7; i < 2 * nr; i += 4) { const int row = r_lo + (i >> 1), s = slots[i];
        ((u32x4*)(AP + (size_t)s * D))[F.tid & 127] = ((const u32x4*)(HN + (size_t)row * D))[F.tid & 127]; }
    __syncthreads();
}

DI void prep_phase(const Params& P, const Frame& F, int L) {
    unsigned char* ws = P.ws;
    LAS float* CW = (LAS float*)F.lds;
    for (int i = F.tid; i < 4 * 2560; i += NTHR) { const int tap = i / 2560, ch = i % 2560;
        CW[i] = ch < 1536 ? P.in[I_CONV_DN][(size_t)(L * 4 + tap) * 1536 + ch] : P.in[I_CONV_ML][(size_t)(L * 4 + tap) * 1024 + ch - 1536]; }
    __syncthreads();
    const int gw = F.bid * NWAVES + F.wave, NGW = F.G * NWAVES;
    const float* GD = (const float*)(ws + WS_GD);
    if (gw < 32) {
        const int b = gw >> 2, h = gw & 3; float m_st = 0.f; float* MLS = (float*)(ws + WS_MLS); float* MLCS = (float*)(ws + WS_MLCS);
        float lfa[32], ipa[32];
#pragma unroll
        for (int n = 0; n < 32; ++n) { const size_t row = (size_t)b * SEQ + 64 * n + F.lane; lfa[n] = GD[row * 16 + 12 + h]; ipa[n] = GD[row * 16 + 8 + h]; }
        float pma[32], bla[32], pxa[32];
#pragma unroll
        for (int n = 0; n < 32; ++n) { const float bc = wave_incl_sum(lfa[n], F.lane); bla[n] = __shfl(bc, 63); const float e = ipa[n] - bc; const float pm = wave_incl_max(e, F.lane); pxa[n] = __shfl(pm, 63);
            lfa[n] = bc; ipa[n] = e; pma[n] = pm; }
#pragma unroll
        for (int n = 0; n < 32; ++n) {
            const size_t row = (size_t)b * SEQ + 64 * n + F.lane;
            const float bc = lfa[n], e = ipa[n], blast = bla[n], pmax = pxa[n];
            const float mt = fmaxf(bc + pma[n], bc + m_st), m_new = fmaxf(blast + m_st, blast + pmax);
            *(f32x4*)(MLS + (row * 4 + h) * 8) = (f32x4){e, bc - mt, __expf(bc + m_st - mt), __expf(-mt)};
            if (F.lane == 0) { MLCS[(b * 4 + h) * 32 + n] = __expf(blast + m_st - m_new); MLCS[NCHUNK + (b * 4 + h) * 32 + n] = __expf(blast + pmax - m_new); }
            m_st = m_new;
        }
    }
    const bf16* Z = (const bf16*)(ws + WS_T + T_Z); bf16* ZC = (bf16*)(ws + WS_T + T_ZC);
    {
        static_assert(M / (GRID * NWAVES) == 8, "prep: 8 rows per wave");
        const int rbeg = gw * 8; const bool hist = (rbeg % SEQ) != 0;
        const __amdgpu_buffer_rsrc_t rz = __builtin_amdgcn_make_buffer_rsrc((void*)Z, 0, 0xFFFFFFFF, 0x00020000), rc = __builtin_amdgcn_make_buffer_rsrc((void*)ZC, 0, 0xFFFFFFFF, 0x00020000);
#pragma unroll 1
        for (int i = 0; i < 5; ++i) {
            const int vo = F.lane * 16 + 1024 * i;
            u32x4 rows[11];
#pragma unroll
            for (int k = 0; k < 11; ++k) rows[k] = (k >= 3 || hist) ? *(const u32x4*)((const unsigned char*)Z + (size_t)(rbeg - 3 + k) * (NZ * 2) + vo) : (u32x4){0u, 0u, 0u, 0u};
            f32x4 w[4][2];
#pragma unroll
            for (int tap = 0; tap < 4; ++tap) { const LAS unsigned char* wp = (const LAS unsigned char*)CW + F.lane * 32 + (tap * 2560 + 512 * i) * 4; w[tap][0] = *(const LAS f32x4*)wp; w[tap][1] = *(const LAS f32x4*)(wp + 16); }
            const float qs = (i == 0 || i == 4) ? 0.08838834764831845f : 1.0f; const bool nrm = i < 2;
#pragma unroll
            for (int r = 0; r < 8; ++r) {
                float a[8];
#pragma unroll
                for (int e = 0; e < 8; ++e) a[e] = 0.f;
#pragma unroll
                for (int tap = 0; tap < 4; ++tap) { const u32x4 x = rows[r + tap];
                    a[0] += bflo(x.x) * w[tap][0][0]; a[1] += bfhi(x.x) * w[tap][0][1]; a[2] += bflo(x.y) * w[tap][0][2]; a[3] += bfhi(x.y) * w[tap][0][3];
                    a[4] += bflo(x.z) * w[tap][1][0]; a[5] += bfhi(x.z) * w[tap][1][1]; a[6] += bflo(x.w) * w[tap][1][2]; a[7] += bfhi(x.w) * w[tap][1][3]; }
                float ss = 0.f;
#pragma unroll
                for (int e = 0; e < 8; ++e) { a[e] = siluf_(a[e]); ss += a[e] * a[e]; }
                ss += shx<1>(ss); ss += shx<2>(ss); ss += shx<4>(ss); ss += shx<8>(ss);
                const float sc = (nrm ? __builtin_amdgcn_rsqf(ss + EPS) : 1.0f) * qs;
                u32x4 o; o.x = pk2(a[0] * sc, a[1] * sc); o.y = pk2(a[2] * sc, a[3] * sc); o.z = pk2(a[4] * sc, a[5] * sc); o.w = pk2(a[6] * sc, a[7] * sc);
                *(u32x4*)((unsigned char*)ZC + (size_t)(rbeg + r) * (2560 * 2) + vo) = o;
            }
        }
    }
    __syncthreads();
}

constexpr int ATT_STAGE = 35840, ATT_KMAP = 9216, ATT_VOFF = 18432, ATT_KRS = 144, ATT_VRS = 272;
DI void attn_block(const Params& P, const Frame& F, int L, int b, int h, int qb, float lam, float oml) {
    unsigned char* ws = P.ws;
    const bf16* Z = (const bf16*)(ws + WS_T + T_Z); bf16* MIX = (bf16*)(ws + WS_T + T_MIX);
    const int lane = F.lane, c = lane & 15, rq = lane >> 4, wave = F.wave;
    const int q0 = qb * 128, qrow = q0 + 16 * wave + c;
    const size_t rowbase = (size_t)b * SEQ;
    bf16x8 qf[2][2];
#pragma unroll
    for (int j = 0; j < 2; ++j)
#pragma unroll
        for (int ks = 0; ks < 2; ++ks) qf[j][ks] = *(const bf16x8*)(Z + (rowbase + qrow) * NZ + 3072 + h * 128 + j * 64 + 32 * ks + 8 * rq);
    const float LOG2E = 1.4426950408889634f;
    const float sc = 0.125f * LOG2E, sl = __builtin_bit_cast(float, __builtin_amdgcn_readfirstlane(__builtin_bit_cast(int, exp2f(-(float)(h + 1)) * LOG2E)));
#pragma unroll
    for (int j = 0; j < 2; ++j)
#pragma unroll
        for (int ks = 0; ks < 2; ++ks) { const u32x4 qv = __builtin_bit_cast(u32x4, qf[j][ks]); u32x4 o;
            o.x = pk2(bflo(qv.x) * sc, bfhi(qv.x) * sc); o.y = pk2(bflo(qv.y) * sc, bfhi(qv.y) * sc); o.z = pk2(bflo(qv.z) * sc, bfhi(qv.z) * sc); o.w = pk2(bflo(qv.w) * sc, bfhi(qv.w) * sc);
            qf[j][ks] = __builtin_bit_cast(bf16x8, o); }
    float sbias[16];
#pragma unroll
    for (int i = 0; i < 16; ++i) sbias[i] = __builtin_bit_cast(float, __builtin_amdgcn_readfirstlane(__builtin_bit_cast(int, sl * (float)(16 * (i >> 2) + (i & 3)))));
    f32x4 O[2][8];
#pragma unroll
    for (int j = 0; j < 2; ++j)
#pragma unroll
        for (int d = 0; d < 8; ++d) O[j][d] = (f32x4){0.f, 0.f, 0.f, 0.f};
    float mrun[2] = {-INFINITY, -INFINITY}, lrun[2] = {0.f, 0.f};
    const int nkt = 2 * (qb + 1);
    u32x4 st[4];
#define ATT_LOAD(kt_) do { const int k0_ = 64 * (kt_); _Pragma("unroll") for (int i_ = 0; i_ < 2; ++i_) { const int id_ = F.tid + 512 * i_, key_ = id_ >> 4, ch_ = id_ & 15; \
        st[i_] = *(const u32x4*)(Z + (rowbase + k0_ + key_) * NZ + 4096 + h * 128 + ch_ * 8); st[2 + i_] = *(const u32x4*)(Z + (rowbase + k0_ + key_) * NZ + 5120 + h * 128 + ch_ * 8); } } while (0)
#define ATT_STORE(s_) do { LAS unsigned char* sb_ = F.lds + (s_) * ATT_STAGE; _Pragma("unroll") for (int i_ = 0; i_ < 2; ++i_) { const int id_ = F.tid + 512 * i_, key_ = id_ >> 4, ch_ = id_ & 15; \
        *(LAS u32x4*)(sb_ + (ch_ >> 3) * ATT_KMAP + key_ * ATT_KRS + (ch_ & 7) * 16) = st[i_]; *(LAS u32x4*)(sb_ + ATT_VOFF + key_ * ATT_VRS + ch_ * 16) = st[2 + i_]; } } while (0)
    ATT_LOAD(nkt - 1); ATT_STORE(0); __syncthreads();
#pragma unroll 1
    for (int kk = 0; kk < nkt; ++kk) {
        const int kt = nkt - 1 - kk;
        if (kk + 1 < nkt) ATT_LOAD(kt - 1);
        const int k0 = 64 * kt;
        if (k0 <= q0 + 16 * wave + 15) {
            const LAS unsigned char* Kb = F.lds + (kk & 1) * ATT_STAGE;
            const unsigned Va = (unsigned)(size_t)(F.lds + (kk & 1) * ATT_STAGE + ATT_VOFF);
            const bool diag = (k0 + 63 > q0 + 16 * wave);
            const int lim = qrow - k0 - 4 * rq;
            const float base2 = sl * (float)(k0 + 4 * rq - qrow);
            bf16x8 pf[2][2];
#pragma unroll
            for (int j = 0; j < 2; ++j) {
                f32x2 x2[8]; float mx = -INFINITY;
#pragma unroll
                for (int nt = 0; nt < 4; ++nt) {
                    f32x4 a = (f32x4){0.f, 0.f, 0.f, 0.f};
#pragma unroll
                    for (int ks = 0; ks < 2; ++ks) a = MFMA16(frag_row(Kb + j * ATT_KMAP, ATT_KRS, 16 * nt, 32 * ks, lane), qf[j][ks], a);
                    x2[2 * nt] = (f32x2){a[0], a[1]} + (f32x2){sbias[4 * nt], sbias[4 * nt + 1]}; x2[2 * nt + 1] = (f32x2){a[2], a[3]} + (f32x2){sbias[4 * nt + 2], sbias[4 * nt + 3]};
                }
                if (diag) {
#pragma unroll
                    for (int i = 0; i < 8; ++i) { x2[i].x = (16 * (i >> 1) + 2 * (i & 1) <= lim) ? x2[i].x : -INFINITY; x2[i].y = (16 * (i >> 1) + 2 * (i & 1) + 1 <= lim) ? x2[i].y : -INFINITY; } }
#pragma unroll
                for (int i = 0; i < 8; ++i) { mx = fmaxf(mx, x2[i].x); mx = fmaxf(mx, x2[i].y); }
                mx += base2;
                mx = fmaxf(mx, shx<16>(mx)); mx = fmaxf(mx, shx<32>(mx));
                const float mnew = fmaxf(mrun[j], mx), alpha = __builtin_amdgcn_exp2f(mrun[j] - mnew), msub = mnew - base2;
                const f32x2 ms2 = (f32x2){msub, msub}; f32x2 ps2 = (f32x2){0.f, 0.f};
#pragma unroll
                for (int i = 0; i < 8; ++i) { const f32x2 t = x2[i] - ms2; x2[i] = (f32x2){__builtin_amdgcn_exp2f(t.x), __builtin_amdgcn_exp2f(t.y)}; ps2 = ps2 + x2[i]; }
                lrun[j] = lrun[j] * alpha + (ps2.x + ps2.y); mrun[j] = mnew;
                if (__builtin_amdgcn_ballot_w64(alpha != 1.0f) != 0ull) {
#pragma unroll
                    for (int d = 0; d < 8; ++d) O[j][d] = O[j][d] * alpha; }
#pragma unroll
                for (int k2 = 0; k2 < 2; ++k2) { u32x4 w; w.x = pk2(x2[4 * k2].x, x2[4 * k2].y); w.y = pk2(x2[4 * k2 + 1].x, x2[4 * k2 + 1].y); w.z = pk2(x2[4 * k2 + 2].x, x2[4 * k2 + 2].y); w.w = pk2(x2[4 * k2 + 3].x, x2[4 * k2 + 3].y);
                    pf[j][k2] = __builtin_bit_cast(bf16x8, w); }
            }
            {
                const int tq = (lane & 15) >> 2, tp = lane & 3;
                const unsigned ab = Va + (unsigned)((4 * rq + tq) * ATT_VRS + 8 * tp);
                s16x4 va[8], vb[8], vc[8], vd[8];
#define ATT_TR8(dst, addr) asm volatile("ds_read_b64_tr_b16 %0, %8\n\tds_read_b64_tr_b16 %1, %8 offset:32\n\tds_read_b64_tr_b16 %2, %8 offset:64\n\tds_read_b64_tr_b16 %3, %8 offset:96\n\t" \
                    "ds_read_b64_tr_b16 %4, %8 offset:128\n\tds_read_b64_tr_b16 %5, %8 offset:160\n\tds_read_b64_tr_b16 %6, %8 offset:192\n\tds_read_b64_tr_b16 %7, %8 offset:224" \
                    : "=&v"(dst[0]), "=&v"(dst[1]), "=&v"(dst[2]), "=&v"(dst[3]), "=&v"(dst[4]), "=&v"(dst[5]), "=&v"(dst[6]), "=&v"(dst[7]) : "v"(addr) : "memory")
                ATT_TR8(va, ab); ATT_TR8(vb, ab + 16 * ATT_VRS);
                asm volatile("s_waitcnt lgkmcnt(0)" : "+v"(va[0]), "+v"(va[1]), "+v"(va[2]), "+v"(va[3]), "+v"(va[4]), "+v"(va[5]), "+v"(va[6]), "+v"(va[7]), "+v"(vb[0]), "+v"(vb[1]), "+v"(vb[2]), "+v"(vb[3]), "+v"(vb[4]), "+v"(vb[5]), "+v"(vb[6]), "+v"(vb[7]) :: "memory");
#pragma unroll
                for (int d = 0; d < 8; ++d) { bf16x8 vf; vf[0] = va[d][0]; vf[1] = va[d][1]; vf[2] = va[d][2]; vf[3] = va[d][3]; vf[4] = vb[d][0]; vf[5] = vb[d][1]; vf[6] = vb[d][2]; vf[7] = vb[d][3];
                    O[0][d] = MFMA16(vf, pf[0][0], O[0][d]); O[1][d] = MFMA16(vf, pf[1][0], O[1][d]); }
                ATT_TR8(vc, ab + 32 * ATT_VRS); ATT_TR8(vd, ab + 48 * ATT_VRS);
                asm volatile("s_waitcnt lgkmcnt(0)" : "+v"(vc[0]), "+v"(vc[1]), "+v"(vc[2]), "+v"(vc[3]), "+v"(vc[4]), "+v"(vc[5]), "+v"(vc[6]), "+v"(vc[7]), "+v"(vd[0]), "+v"(vd[1]), "+v"(vd[2]), "+v"(vd[3]), "+v"(vd[4]), "+v"(vd[5]), "+v"(vd[6]), "+v"(vd[7]) :: "memory");
#pragma unroll
                for (int d = 0; d < 8; ++d) { bf16x8 vf; vf[0] = vc[d][0]; vf[1] = vc[d][1]; vf[2] = vc[d][2]; vf[3] = vc[d][3]; vf[4] = vd[d][0]; vf[5] = vd[d][1]; vf[6] = vd[d][2]; vf[7] = vd[d][3];
                    O[0][d] = MFMA16(vf, pf[0][1], O[0][d]); O[1][d] = MFMA16(vf, pf[1][1], O[1][d]); }
#undef ATT_TR8
            }
        }
        if (kk + 1 < nkt) ATT_STORE((kk + 1) & 1);
        __syncthreads();
    }
#undef ATT_LOAD
#undef ATT_STORE
    const float* nw = P.in[I_DIFF_NORM] + L * 128;
    f32x4 nwv[8];
#pragma unroll
    for (int d = 0; d < 8; ++d) nwv[d] = *(const f32x4*)(nw + 16 * d + 4 * rq);
    float inv[2];
#pragma unroll
    for (int j = 0; j < 2; ++j) { float l = lrun[j]; l += shx<16>(l); l += shx<32>(l); inv[j] = __builtin_amdgcn_rcpf(l); }
    const float inv1l = lam * inv[1];
    float ss = 0.f;
#pragma unroll
    for (int d = 0; d < 8; ++d)
#pragma unroll
        for (int e = 0; e < 4; ++e) { const float o = O[0][d][e] * inv[0] - O[1][d][e] * inv1l; O[0][d][e] = o; ss += o * o; }
    ss += shx<16>(ss); ss += shx<32>(ss);
    const float r = oml * __builtin_amdgcn_rsqf(ss * (1.0f / 128.0f) + EPS);
    unsigned long long ov[8];
#pragma unroll
    for (int d = 0; d < 8; ++d) ov[d] = (unsigned long long)pk2(O[0][d][0] * r * nwv[d][0], O[0][d][1] * r * nwv[d][1]) | ((unsigned long long)pk2(O[0][d][2] * r * nwv[d][2], O[0][d][3] * r * nwv[d][3]) << 32);
#pragma unroll
    for (int d = 0; d < 8; ++d) *(unsigned long long*)(MIX + (rowbase + qrow) * D + 512 + h * 128 + 16 * d + 4 * rq) = ov[d];
}

template <int NW> DI void dn1_unit(const Params& P, const Frame& F, int cidx) {
    constexpr int NT = NW * 64;
    unsigned char* ws = P.ws;
    const int bh = cidx >> 5, n = cidx & 31, b = bh >> 2, h = bh & 3; const size_t r0 = (size_t)b * SEQ + 64 * n;
    const bf16* ZC = (const bf16*)(ws + WS_T + T_ZC); const float* GD = (const float*)(ws + WS_GD);
    LAS unsigned char* Qs = F.lds + 16896; LAS unsigned char* Ks = F.lds + 34304; LAS unsigned char* Vs = F.lds + 51712;
    LAS float* Am = (LAS float*)(F.lds); LAS float* gcs = (LAS float*)(F.lds + 16384); LAS float* bts = (LAS float*)(F.lds + 16640);
    const int lane = F.lane, c = lane & 15, rq = lane >> 4;
    for (int id = F.tid; id < 3072; id += NT) { const int which = id >> 10, rem = id & 1023, row = rem >> 4, ch = rem & 15;
        *(LAS u32x4*)(Qs + which * 17408 + row * 272 + ch * 16) = *(const u32x4*)(ZC + (r0 + row) * 2560 + which * 512 + h * 128 + ch * 8); }
    if (F.tid < 64) { bts[F.tid] = GD[(r0 + F.tid) * 16 + h]; const float gc = wave_incl_sum(GD[(r0 + F.tid) * 16 + 4 + h], lane); gcs[F.tid] = gc;
        if (lane == 63) ((float*)(ws + WS_DNGL))[cidx] = __expf(gc); }
    __syncthreads();
    bf16* ATT = (bf16*)(ws + WS_T + T_ATT) + (size_t)cidx * 4096;
    for (int ti = 0; ti < 32 / NW; ++ti) {
        const int idx = F.wave * (32 / NW) + ti, isqk = idx >> 4, mt = (idx & 15) >> 2, nt = idx & 3;
        if (!isqk && mt < nt) continue;
        f32x4 a = (f32x4){0.f, 0.f, 0.f, 0.f};
        if (mt >= nt) {
#pragma unroll
            for (int ks = 0; ks < 4; ++ks) a = MFMA16(frag_row(isqk ? Qs : Ks, 272, 16 * mt, 32 * ks, lane), frag_row(Ks, 272, 16 * nt, 32 * ks, lane), a);
        }
        const int j = 16 * nt + c; const float gj = gcs[j];
#pragma unroll
        for (int e = 0; e < 4; ++e) { const int i = 16 * mt + 4 * rq + e; const float dec = __expf(gcs[i] - gj);
            if (!isqk) Am[i * 64 + j] = (i > j) ? bts[i] * a[e] * dec : 0.f;
            else ATT[i * 64 + j] = (bf16)f2bf((i >= j) ? a[e] * dec : 0.f); }
    }
    __syncthreads();
    if (NW == 4 || F.wave < 4) {
        const int cc = F.tid, d = cc & 127; const bool isw = cc >= 128;
        const LAS unsigned char* srcT = (isw ? Ks : Vs) + d * 2;
        float* up = (float*)(ws + WS_T + T_U) + r0 * 512 + h * 128 + d; bf16* wp = (bf16*)(ws + WS_T + T_W) + r0 * 512 + h * 128 + d;
        float x[64];
#pragma unroll
        for (int i = 0; i < 64; ++i) {
            const float gm = isw ? __expf(gcs[i]) : 1.0f;
            float acc = bf2f(*(const LAS bf16*)(srcT + i * 272)) * bts[i] * gm;
            float pa[4] = {0.f, 0.f, 0.f, 0.f};
#pragma unroll
            for (int j4 = 0; j4 < (i + 3) / 4; ++j4) { const f32x4 av = *(const LAS f32x4*)(Am + i * 64 + 4 * j4);
#pragma unroll
                for (int e = 0; e < 4; ++e) if (4 * j4 + e < i) pa[e] += av[e] * x[4 * j4 + e]; }
            acc -= (pa[0] + pa[1]) + (pa[2] + pa[3]);
            x[i] = acc;
            if (isw) *wp = (bf16)f2bf(acc); else *up = acc;
            up += 512; wp += 512; asm volatile("" : "+v"(up), "+v"(wp));
        }
    }
    if (NW == 4 || F.wave >= 4) {
        const int t = (NW == 4) ? F.tid : F.tid - 256;
        bf16* QG = (bf16*)(ws + WS_T + T_QG); bf16* KGT = (bf16*)(ws + WS_T + T_KGT) + (size_t)cidx * 8192;
        for (int idx = t; idx < 1024; idx += 256) { const int row = idx >> 4, ch = idx & 15; const u32x4 q = *(const LAS u32x4*)(Qs + row * 272 + ch * 16); const float eg = __expf(gcs[row]);
            u32x4 o; o.x = pk2(bflo(q.x) * eg, bfhi(q.x) * eg); o.y = pk2(bflo(q.y) * eg, bfhi(q.y) * eg); o.z = pk2(bflo(q.z) * eg, bfhi(q.z) * eg); o.w = pk2(bflo(q.w) * eg, bfhi(q.w) * eg);
            *(u32x4*)(QG + (r0 + row) * 512 + h * 128 + ch * 8) = o; }
        const float glast = gcs[63];
        for (int idx = t; idx < 1024; idx += 256) { const int dd = idx >> 3, ic = idx & 7; float v[8];
#pragma unroll
            for (int e = 0; e < 8; ++e) { const int i = 8 * ic + e; v[e] = bf2f(*(const LAS bf16*)(Ks + i * 272 + dd * 2)) * __expf(glast - gcs[i]); }
            u32x4 o; o.x = pk2(v[0], v[1]); o.y = pk2(v[2], v[3]); o.z = pk2(v[4], v[5]); o.w = pk2(v[6], v[7]);
            *(u32x4*)(KGT + dd * 64 + 8 * ic) = o; }
    }
    __syncthreads();
}

template <int NW> DI void ml1_unit(const Params& P, const Frame& F, int cidx) {
    constexpr int NT = NW * 64;
    unsigned char* ws = P.ws;
    const int bh = cidx >> 5, n = cidx & 31, b = bh >> 2, h = bh & 3; const size_t r0 = (size_t)b * SEQ + 64 * n;
    const bf16* Z = (const bf16*)(ws + WS_T + T_Z); const bf16* ZC = (const bf16*)(ws + WS_T + T_ZC); const float* MLS = (const float*)(ws + WS_MLS);
    LAS unsigned char* Vs = F.lds; LAS unsigned char* KWs = F.lds + 17408;
    const int lane = F.lane, c = lane & 15, rq = lane >> 4;
    LAS float* wl = (LAS float*)(F.lds + 34816);
    { const float* GD = (const float*)(ws + WS_GD);
      if (F.tid < 64) { const float lf = GD[(r0 + F.tid) * 16 + 12 + h], ip = GD[(r0 + F.tid) * 16 + 8 + h]; const float e = ip - wave_incl_sum(lf, lane); wl[F.tid] = __expf(e - wave_max(e)); } }
    __syncthreads();
    for (int id = F.tid; id < 2048; id += NT) { const int which = id >> 10, rem = id & 1023, row = rem >> 4, ch = rem & 15;
        if (which == 0) *(LAS u32x4*)(Vs + row * 272 + ch * 16) = *(const u32x4*)(Z + (r0 + row) * NZ + 6144 + h * 128 + ch * 8);
        else { const u32x4 k = *(const u32x4*)(ZC + (r0 + row) * 2560 + 2048 + h * 128 + ch * 8); const float w = wl[row];
            u32x4 o; o.x = pk2(bflo(k.x) * w, bfhi(k.x) * w); o.y = pk2(bflo(k.y) * w, bfhi(k.y) * w); o.z = pk2(bflo(k.z) * w, bfhi(k.z) * w); o.w = pk2(bflo(k.w) * w, bfhi(k.w) * w);
            *(LAS u32x4*)(KWs + row * 272 + ch * 16) = o; } }
    __syncthreads();
    float* DCT = (float*)(ws + WS_T + T_DCT) + (size_t)cidx * 16512;
    const unsigned Va = (unsigned)(size_t)Vs, Ka = (unsigned)(size_t)KWs;
#pragma unroll
    for (int mi = 0; mi < 8 / NW; ++mi) { const int mt = F.wave + NW * mi;
        bf16x8 af[2];
#pragma unroll
        for (int ks = 0; ks < 2; ++ks) af[ks] = frag_tr(Va, 272, 32 * ks, 16 * mt, lane);
#pragma unroll
        for (int nt = 0; nt < 8; ++nt) { f32x4 a = (f32x4){0.f, 0.f, 0.f, 0.f};
#pragma unroll
            for (int ks = 0; ks < 2; ++ks) a = MFMA16(af[ks], frag_tr(Ka, 272, 32 * ks, 16 * nt, lane), a);
#pragma unroll
            for (int e = 0; e < 4; ++e) DCT[(16 * mt + 4 * rq + e) * 128 + 16 * nt + c] = a[e]; } }
    if (F.tid < 128) { float s = 0.f; for (int j = 0; j < 64; ++j) s += bf2f(*(const LAS bf16*)(KWs + j * 272 + F.tid * 2)); DCT[128 * 128 + F.tid] = s; }
    __syncthreads();
}

DI void ml2_scan(const Params& P, int gt, int NGT) {
    unsigned char* ws = P.ws;
    const float* DCT = (const float*)(ws + WS_T + T_DCT); bf16* CST = (bf16*)(ws + WS_T + T_CST); const float* MLCS = (const float*)(ws + WS_MLCS);
    for (int g = gt; g < 32 * 4128; g += NGT) { const int bh = g / 4128, idx = (g % 4128) * 4; f32x4 cst = (f32x4){0.f, 0.f, 0.f, 0.f};
#pragma unroll 1
        for (int n0 = 0; n0 < 32; n0 += 8) { f32x4 d[8]; float cs[8];
#pragma unroll
            for (int k = 0; k < 8; ++k) { const int cid = bh * 32 + n0 + k; d[k] = *(const f32x4*)(DCT + (size_t)cid * 16512 + idx) * MLCS[NCHUNK + cid]; cs[k] = MLCS[cid]; }
#pragma unroll
            for (int k = 0; k < 8; ++k) { const int cid = bh * 32 + n0 + k;
                *(unsigned long long*)(CST + (size_t)cid * 18432 + idx) = (unsigned long long)pk2(cst[0], cst[1]) | ((unsigned long long)pk2(cst[2], cst[3]) << 32);
                cst = cs[k] * cst + d[k]; } } }
}

DI void head_gate_load(const Frame& F, const bf16* gsrc  , u32x4& g0, u32x4& g1) {
    const int row = F.tid >> 3, seg = F.tid & 7;
    g0 = *(const u32x4*)(gsrc + (size_t)row * NZ + 16 * seg); g1 = *(const u32x4*)(gsrc + (size_t)row * NZ + 16 * seg + 8);
}
DI void head_nw_load(const Frame& F, const float* nw, f32x4 (&nwv)[4]) { const int seg = F.tid & 7;
#pragma unroll
    for (int q = 0; q < 4; ++q) nwv[q] = *(const f32x4*)(nw + 16 * seg + 4 * q); }
template <int GATE> DI void head_norm_store(const Frame& F, const LAS float* Hs, const f32x4 (&nwv)[4], const u32x4 g0, const u32x4 g1, bf16* dst  ) {
    const int row = F.tid >> 3, seg = F.tid & 7;
    float v[16]; float ss = 0.f;
#pragma unroll
    for (int e = 0; e < 16; ++e) { v[e] = Hs[row * 132 + 16 * seg + e]; ss += v[e] * v[e]; }
    ss += shx<1>(ss); ss += shx<2>(ss); ss += shx<4>(ss);
    const float r = 1.0f / sqrtf(ss * (1.0f / 128.0f) + EPS);
    float gt[16] = {bflo(g0.x), bfhi(g0.x), bflo(g0.y), bfhi(g0.y), bflo(g0.z), bfhi(g0.z), bflo(g0.w), bfhi(g0.w), bflo(g1.x), bfhi(g1.x), bflo(g1.y), bfhi(g1.y), bflo(g1.z), bfhi(g1.z), bflo(g1.w), bfhi(g1.w)};
#pragma unroll
    for (int e = 0; e < 16; ++e) v[e] = v[e] * r * nwv[e >> 2][e & 3] * (GATE == 0 ? siluf_(gt[e]) : sigmoidf_(gt[e]));
    u32x4 o0, o1; o0.x = pk2(v[0], v[1]); o0.y = pk2(v[2], v[3]); o0.z = pk2(v[4], v[5]); o0.w = pk2(v[6], v[7]); o1.x = pk2(v[8], v[9]); o1.y = pk2(v[10], v[11]); o1.z = pk2(v[12], v[13]); o1.w = pk2(v[14], v[15]);
    *(u32x4*)(dst + (size_t)row * D + 16 * seg) = o0; *(u32x4*)(dst + (size_t)row * D + 16 * seg + 8) = o1;
}

struct Dn2A { bf16x8 wf[4]; };
struct Dn2B { bf16x8 qf[4], af[2], kf[2]; float gl; };
DI void dn2_load_a(const Params& P, const Frame& F, int bh, int n, Dn2A& o) {
    unsigned char* ws = P.ws;
    const int b = bh >> 2, h = bh & 3, lane = F.lane, c = lane & 15, rq = lane >> 4, w = F.wave, mt = w >> 1;
    const size_t r0 = (size_t)b * SEQ + 64 * n;
    const bf16* W = (const bf16*)(ws + WS_T + T_W);
#pragma unroll
    for (int ks = 0; ks < 4; ++ks) o.wf[ks] = *(const bf16x8*)(W + (r0 + 16 * mt + c) * 512 + h * 128 + 32 * ks + 8 * rq);
}
DI void dn2_load_u(const Params& P, const Frame& F, int bh, int n, float (&u)[4][4]) {
    unsigned char* ws = P.ws;
    const int b = bh >> 2, h = bh & 3, lane = F.lane, c = lane & 15, rq = lane >> 4, w = F.wave, mt = w >> 1, ntb = (w & 1) * 4;
    const size_t r0 = (size_t)b * SEQ + 64 * n; const float* U = (const float*)(ws + WS_T + T_U);
#pragma unroll
    for (int t = 0; t < 4; ++t)
#pragma unroll
        for (int e = 0; e < 4; ++e) u[t][e] = U[(r0 + 16 * mt + 4 * rq + e) * 512 + h * 128 + 16 * (ntb + t) + c];
}
DI void dn2_load_b(const Params& P, const Frame& F, int bh, int n, Dn2B& o) {
    unsigned char* ws = P.ws;
    const int b = bh >> 2, h = bh & 3, lane = F.lane, c = lane & 15, rq = lane >> 4, w = F.wave, mt = w >> 1;
    const int cid = bh * 32 + n; const size_t r0 = (size_t)b * SEQ + 64 * n;
    const bf16* QG = (const bf16*)(ws + WS_T + T_QG);
    const bf16* ATT = (const bf16*)(ws + WS_T + T_ATT) + (size_t)cid * 4096; const bf16* KGT = (const bf16*)(ws + WS_T + T_KGT) + (size_t)cid * 8192;
    o.gl = ((const float*)(ws + WS_DNGL))[cid];
#pragma unroll
    for (int ks = 0; ks < 4; ++ks) o.qf[ks] = *(const bf16x8*)(QG + (r0 + 16 * mt + c) * 512 + h * 128 + 32 * ks + 8 * rq);
#pragma unroll
    for (int ks = 0; ks < 2; ++ks) { o.af[ks] = *(const bf16x8*)(ATT + (16 * mt + c) * 64 + 32 * ks + 8 * rq); o.kf[ks] = *(const bf16x8*)(KGT + (16 * w + c) * 64 + 32 * ks + 8 * rq); }
}
DI void dn2_block(const Params& P, const Frame& F, int L, int bh) {
    unsigned char* ws = P.ws;
    const int b = bh >> 2, h = bh & 3, lane = F.lane, c = lane & 15, rq = lane >> 4, w = F.wave;
    LAS unsigned char* St0 = F.lds; LAS unsigned char* VnT = F.lds + 69632; LAS float* Os = (LAS float*)(F.lds + 88064);
    bf16* MIX = (bf16*)(ws + WS_T + T_MIX);
    for (int i = F.tid; i < 34816 / 16; i += NTHR) ((LAS u32x4*)St0)[i] = (u32x4){0u, 0u, 0u, 0u};
    f32x4 sreg[8];
#pragma unroll
    for (int nt = 0; nt < 8; ++nt) sreg[nt] = (f32x4){0.f, 0.f, 0.f, 0.f};
    LAS float* nws = (LAS float*)(F.lds + 121856); if (F.tid < 128) nws[F.tid] = P.in[I_DN_NORM][L * 128 + F.tid];
    Dn2A cur, nxt; Dn2B ob; u32x4 gp0 = (u32x4){0u, 0u, 0u, 0u}, gp1 = gp0;
    dn2_load_a(P, F, bh, 0, cur);
    __syncthreads();
    const int mt = w >> 1, ntb = (w & 1) * 4;
#pragma unroll 1
    for (int n = 0; n < 32; ++n) {
        const int p = n & 1; const size_t r0 = (size_t)b * SEQ + 64 * n;
        const LAS unsigned char* Sp = St0 + p * 34816; LAS unsigned char* Sn = St0 + (1 - p) * 34816;
        float uu[4][4]; dn2_load_u(P, F, bh, n, uu);
        u32x4 g0, g1; head_gate_load(F, (const bf16*)(ws + WS_T + T_Z) + r0 * NZ + 2560 + h * 128, g0, g1);
        dn2_load_b(P, F, bh, n, ob);
        dn2_load_a(P, F, bh, n + 1 < 32 ? n + 1 : n, nxt);
        f32x4 va[4];
#pragma unroll
        for (int t = 0; t < 4; ++t) { const int nt = ntb + t; f32x4 a = (f32x4){0.f, 0.f, 0.f, 0.f};
#pragma unroll
            for (int ks = 0; ks < 4; ++ks) a = MFMA16(cur.wf[ks], frag_row(Sp, 272, 16 * nt, 32 * ks, lane), a);
            va[t] = a; }
        if (n > 0) { f32x4 nwv[4]; const int seg = F.tid & 7;
#pragma unroll
            for (int q = 0; q < 4; ++q) nwv[q] = *(const LAS f32x4*)(nws + 16 * seg + 4 * q);
            head_norm_store<0>(F, Os, nwv, gp0, gp1, MIX + (r0 - 64) * D + h * 128); }
#pragma unroll
        for (int t = 0; t < 4; ++t) { const int nt = ntb + t;
            *(LAS unsigned long long*)(VnT + (16 * nt + c) * 144 + (16 * mt + 4 * rq) * 2) = (unsigned long long)pk2(uu[t][0] - va[t][0], uu[t][1] - va[t][1]) | ((unsigned long long)pk2(uu[t][2] - va[t][2], uu[t][3] - va[t][3]) << 32); }
        lds_barrier();
#pragma unroll
        for (int t = 0; t < 4; ++t) { const int nt = ntb + t; f32x4 a = (f32x4){0.f, 0.f, 0.f, 0.f};
#pragma unroll
            for (int ks = 0; ks < 4; ++ks) a = MFMA16(ob.qf[ks], frag_row(Sp, 272, 16 * nt, 32 * ks, lane), a);
#pragma unroll
            for (int ks = 0; ks < 2; ++ks) a = MFMA16(ob.af[ks], frag_row(VnT, 144, 16 * nt, 32 * ks, lane), a);
#pragma unroll
            for (int e = 0; e < 4; ++e) Os[(16 * mt + 4 * rq + e) * 132 + 16 * nt + c] = a[e]; }
#pragma unroll
        for (int nt = 0; nt < 8; ++nt) { f32x4 a = sreg[nt] * ob.gl;
#pragma unroll
            for (int ks = 0; ks < 2; ++ks) a = MFMA16(ob.kf[ks], frag_row(VnT, 144, 16 * nt, 32 * ks, lane), a);
            sreg[nt] = a;
            *(LAS unsigned long long*)(Sn + (16 * nt + c) * 272 + (16 * w + 4 * rq) * 2) = (unsigned long long)pk2(a[0], a[1]) | ((unsigned long long)pk2(a[2], a[3]) << 32); }
        lds_barrier();
        gp0 = g0; gp1 = g1; cur = nxt;
    }
    { f32x4 nwv[4]; const int seg = F.tid & 7;
#pragma unroll
      for (int q = 0; q < 4; ++q) nwv[q] = *(const LAS f32x4*)(nws + 16 * seg + 4 * q);
      head_norm_store<0>(F, Os, nwv, gp0, gp1, MIX + ((size_t)b * SEQ + 64 * 31) * D + h * 128); }
    __syncthreads();
}

DI void ml3_unit(const Params& P, const Frame& F, int L, int cidx) {
    unsigned char* ws = P.ws;
    const int bh = cidx >> 5, n = cidx & 31, b = bh >> 2, h = bh & 3; const size_t r0 = (size_t)b * SEQ + 64 * n;
    const bf16* Z = (const bf16*)(ws + WS_T + T_Z); const bf16* ZC = (const bf16*)(ws + WS_T + T_ZC); const float* MLS = (const float*)(ws + WS_MLS);
    const bf16* CST = (const bf16*)(ws + WS_T + T_CST) + (size_t)cidx * 18432; bf16* MIX = (bf16*)(ws + WS_T + T_MIX);
    LAS unsigned char* Qs = F.lds; LAS unsigned char* Ks = F.lds + 17408; LAS unsigned char* Vx = F.lds + 34816; LAS unsigned char* Cs = F.lds + 54272; LAS unsigned char* Sm = F.lds + 93440;
    LAS float* sA = (LAS float*)(F.lds + 102656); LAS float* ej = sA + 64; LAS float* inter = sA + 128; LAS float* flo = sA + 192; LAS float* den1 = sA + 256; LAS float* qn = sA + 320;
    LAS float* Hs = (LAS float*)F.lds;
    const int lane = F.lane, c = lane & 15, rq = lane >> 4, w = F.wave;
    for (int id = F.tid; id < 3072; id += NTHR) { const int which = id >> 10, rem = id & 1023, row = rem >> 4, ch = rem & 15;
        if (which == 0) *(LAS u32x4*)(Qs + row * 272 + ch * 16) = *(const u32x4*)(ZC + (r0 + row) * 2560 + 1536 + h * 128 + ch * 8);
        else if (which == 1) *(LAS u32x4*)(Ks + row * 272 + ch * 16) = *(const u32x4*)(ZC + (r0 + row) * 2560 + 2048 + h * 128 + ch * 8);
        else *(LAS u32x4*)(Vx + row * 304 + ch * 16) = *(const u32x4*)(Z + (r0 + row) * NZ + 6144 + h * 128 + ch * 8); }
    if (F.tid < 128) { const int row = F.tid >> 1, which = F.tid & 1; *(LAS u32x4*)(Vx + row * 304 + 256 + which * 16) = (u32x4){which == 0 ? 0x00003F80u : 0u, 0u, 0u, 0u}; }
    for (int id = F.tid; id < 2304; id += NTHR) { const int row = id >> 4, ch = id & 15; *(LAS u32x4*)(Cs + row * 272 + ch * 16) = *(const u32x4*)(CST + row * 128 + ch * 8); }
    if (F.tid < 64) { const float* s = MLS + ((r0 + F.tid) * 4 + h) * 8; ej[F.tid] = s[0]; sA[F.tid] = s[1]; inter[F.tid] = s[2]; flo[F.tid] = s[3]; }
    __syncthreads();
#pragma unroll
    for (int ti = 0; ti < 2; ++ti) { const int idx = 2 * w + ti, mt = idx >> 2, nt = idx & 3; f32x4 a = (f32x4){0.f, 0.f, 0.f, 0.f};
        if (mt >= nt) {
#pragma unroll
            for (int ks = 0; ks < 4; ++ks) a = MFMA16(frag_row(Qs, 272, 16 * mt, 32 * ks, lane), frag_row(Ks, 272, 16 * nt, 32 * ks, lane), a);
        }
        const int j = 16 * nt + c; const float e_j = ej[j];
#pragma unroll
        for (int e = 0; e < 4; ++e) { const int i = 16 * mt + 4 * rq + e; *(LAS bf16*)(Sm + i * 144 + j * 2) = (bf16)f2bf((i >= j) ? a[e] * __expf(sA[i] + e_j) : 0.f); } }
    const int mt = w >> 1, ntb = (w & 1) * 4;
    f32x4 acc2[4], acc1[4], a29 = (f32x4){0.f, 0.f, 0.f, 0.f}, a19 = (f32x4){0.f, 0.f, 0.f, 0.f};
    { bf16x8 qf[4];
#pragma unroll
      for (int ks = 0; ks < 4; ++ks) qf[ks] = frag_row(Qs, 272, 16 * mt, 32 * ks, lane);
#pragma unroll
      for (int t = 0; t < 4; ++t) { f32x4 a = (f32x4){0.f, 0.f, 0.f, 0.f};
#pragma unroll
          for (int ks = 0; ks < 4; ++ks) a = MFMA16(qf[ks], frag_row(Cs, 272, 16 * (ntb + t), 32 * ks, lane), a);
          acc2[t] = a; }
      if ((w & 1) == 0) {
#pragma unroll
          for (int ks = 0; ks < 4; ++ks) a29 = MFMA16(qf[ks], frag_row(Cs, 272, 128, 32 * ks, lane), a29); } }
    __syncthreads();
    { const unsigned Va = (unsigned)(size_t)Vx; bf16x8 sf[2];
#pragma unroll
      for (int ks = 0; ks < 2; ++ks) sf[ks] = frag_row(Sm, 144, 16 * mt, 32 * ks, lane);
#pragma unroll
      for (int t = 0; t < 4; ++t) { f32x4 a = (f32x4){0.f, 0.f, 0.f, 0.f};
#pragma unroll
          for (int ks = 0; ks < 2; ++ks) a = MFMA16(sf[ks], frag_tr(Va, 304, 32 * ks, 16 * (ntb + t), lane), a);
          acc1[t] = a; }
      if ((w & 1) == 0) {
#pragma unroll
          for (int ks = 0; ks < 2; ++ks) a19 = MFMA16(sf[ks], frag_tr(Va, 304, 32 * ks, 128, lane), a19);
          if (c == 0) {
#pragma unroll
              for (int e = 0; e < 4; ++e) { den1[16 * mt + 4 * rq + e] = a19[e]; qn[16 * mt + 4 * rq + e] = a29[e]; } } } }
    __syncthreads();
#pragma unroll
    for (int t = 0; t < 4; ++t)
#pragma unroll
        for (int e = 0; e < 4; ++e) { const int i = 16 * mt + 4 * rq + e; const float it = inter[i], den = den1[i] + it * qn[i];
            Hs[i * 132 + 16 * (ntb + t) + c] = (acc1[t][e] + it * acc2[t][e]) / fmaxf(fabsf(den), flo[i]); }
    __syncthreads();
    { u32x4 g0, g1; f32x4 nwv[4]; head_gate_load(F, Z + r0 * NZ + 6656 + h * 128, g0, g1); head_nw_load(F, P.in[I_ML_NORM] + L * 128, nwv); head_norm_store<1>(F, Hs, nwv, g0, g1, MIX + r0 * D + 1536 + h * 128); }
    __syncthreads();
}

constexpr int NPH = 28;
#ifndef MK_SPLIT
#define MK_SPLIT 0
#endif

#define PH_SETUP() { int l_ = __builtin_amdgcn_mbcnt_hi(~0u, __builtin_amdgcn_mbcnt_lo(~0u, 0u)); asm volatile("" : "+v"(l_)); F.lane = l_; F.tid = F.wave * 64 + l_; }
#define PH_BEGIN(k, kind) if (lo <= (k) && (k) < hi) { PH_SETUP()
#define PH_END(k) if ((k) + 1 < hi) xcd_barrier(bar); }
template <int L> DI void layer_phases(const Params& P, Frame& F, const XcdBarrier& bar, int lo, int hi) {
    unsigned char* ws = P.ws;
    LAS unsigned char* ring = F.lds;
    bf16* HN = (bf16*)(ws + WS_HN);
    bf16* H = (bf16*)(ws + WS_H) + (size_t)L * M * D; bf16* Hnext = (bf16*)(ws + WS_H) + (size_t)M * D;
        const int pb = 1 + 13 * L;
        const void* hin = (L == 0) ? (const void*)P.in[I_X] : (const void*)H;
        PH_BEGIN(pb + 0, 0) norm_phase<1, L == 1>(P, F, L, hin, P.in[I_ATTN_NORM] + L * D, false); PH_END(pb + 0)
        PH_BEGIN(pb + 1, 1) {
            const int gg = (L == 0) ? GRID - NCONV : GRID;
            if (F.bid < gg) {
                pg8::Gemm g{HN, (const bf16*)(ws + WS_WIN) + (size_t)L * NZ * D, M, NZ, D, 0, 0}; pg8::StaticOrder S; S.init(M, NZ, gg, F.bid);
                pg8::EpiBf16Plain E{(bf16*)(ws + WS_T + T_Z), NZ};
                pg8::gemm_phase<pg8::EpiBf16Plain, pg8::StaticOrder, true, true>(ring, g, S, E, F.wave); }
            else prologue_phase<1>(P, F); }
        PH_END(pb + 1)
        PH_BEGIN(pb + 2, 2) {
            prep_phase(P, F, L);
            static_assert(GRID * 64 == M && SEQ / 64 == 32, "one 64-row chunk per workgroup");
            Frame Hf = F; const int half = F.wave >> 2, cb = F.bid >> 5, cn = F.bid & 31; Hf.tid = F.tid & 255; Hf.wave = F.wave & 3;
            Hf.lds = F.lds + half * 69120;
#pragma unroll 1
            for (int hh = 0; hh < 2; ++hh) dn1_unit<4>(P, Hf, ((cb * 4 + 2 * half + hh) * 32 + cn));
            Hf.lds = F.lds + half * 35328;
#pragma unroll 1
            for (int hh = 0; hh < 2; ++hh) ml1_unit<4>(P, Hf, ((cb * 4 + 2 * half + hh) * 32 + cn)); }
        PH_END(pb + 2)
        PH_BEGIN(pb + 4, 4) {
            if (F.bid < 32) dn2_block(P, F, L, F.bid); else ml2_scan(P, (F.bid - 32) * NTHR + F.tid, (F.G - 32) * NTHR);
            const float li = (L == 0) ? 0.2f : 0.35550906759f;
            const float d1 = wave_sum(P.in[I_LQ1][L * 64 + F.lane] * P.in[I_LK1][L * 64 + F.lane]), d2 = wave_sum(P.in[I_LQ2][L * 64 + F.lane] * P.in[I_LK2][L * 64 + F.lane]);
            const float lam = __expf(d1) - __expf(d2) + li;
            unsigned* qctr = (unsigned*)(ws + WS_CTL) + CW_QUEUE + 64 * L;
            for (;;) {
                __syncthreads();
                if (F.tid == 0) F.MISC[24] = __hip_atomic_fetch_add(qctr, 1u, __ATOMIC_RELAXED, __HIP_MEMORY_SCOPE_AGENT);
                __syncthreads();
                const int u = (int)F.MISC[24];
                if (u >= 1024) break;
                const int bh = u & 63; attn_block(P, F, L, bh >> 3, bh & 7, 15 - (u >> 6), lam, 1.0f - li); } }
        PH_END(pb + 4)
        PH_BEGIN(pb + 5, 5) for (int u = F.bid; u < NCHUNK; u += F.G) ml3_unit(P, F, L, u); PH_END(pb + 5)
        PH_BEGIN(pb + 6, 6) {
            pg8::Gemm g{(const bf16*)(ws + WS_T + T_MIX), (const bf16*)(ws + WS_WOUT) + (size_t)L * D * D, M, D, D, 0, 0}; pg8::StaticOrder S; S.init(M, D, F.G, F.bid);
            pg8::EpiRes<1, L == 0, false> E{H, hin, nullptr, D, nullptr, nullptr, nullptr};
            pg8::gemm_phase<pg8::EpiRes<1, L == 0, false>, pg8::StaticOrder, true, true>(ring, g, S, E, F.wave); }
        PH_END(pb + 6)
        if (L == 0) {
            PH_BEGIN(pb + 7, 7) norm_phase<0, true>(P, F, L, H, P.in[I_FFN_NORM] + L * D, false); PH_END(pb + 7)
            PH_BEGIN(pb + 9, 9) {
                pg8::Gemm g{HN, (const bf16*)(ws + WS_WGU), M, 2 * DFF, D / 2, SB(LS_HN), SB(LS_WGU)}; pg8::StaticOrder S; S.init(M, 2 * DFF, F.G, F.bid);
                pg8::EpiSwiGLU<true> E{(unsigned char*)(ws + WS_T + T_ACT), DFF, (float)(1 << LS_ACT), nullptr};
                pg8::gemm_phase<pg8::EpiSwiGLU<true>, pg8::StaticOrder, true, true, true>(ring, g, S, E, F.wave); }
            PH_END(pb + 9)
            PH_BEGIN(pb + 10, 10) {
                pg8::Gemm g{(const bf16*)(ws + WS_T + T_ACT), (const bf16*)(ws + WS_WD), M, D, DFF / 2, SB(LS_ACT), SB(LS_WD)}; pg8::StaticOrder S; S.init(M, D, F.G, F.bid);
                pg8::EpiRes<1, false, true> E{H, H, nullptr, D, (float*)(ws + WS_T + T_SS), (LAS float*)(F.lds + MISC_OFF + 1024), nullptr};
                pg8::gemm_phase<pg8::EpiRes<1, false, true>, pg8::StaticOrder, true, true, true>(ring, g, S, E, F.wave); }
            PH_END(pb + 10)
        } else {
            PH_BEGIN(pb + 7, 7) norm_phase<2, true>(P, F, L, H, P.in[I_FFN_NORM] + L * D, false); PH_END(pb + 7)
            PH_BEGIN(pb + 8, 8) moe_gather_phase(P, F); PH_END(pb + 8)
            PH_BEGIN(pb + 9, 9) {
                const int* TILE_E = (const int*)(ws + WS_TILEE); const int ntile = __builtin_amdgcn_readfirstlane(TILE_E[255]);
                unsigned* mcnt = (unsigned*)(ws + WS_CTL) + CW_MOECNT;
                { pg8::Gemm g{(const bf16*)(ws + WS_T + T_APERM), (const bf16*)(ws + WS_MGU), ntile * 256, 2 * DFF, D / 2, SB(LS_HN), SB(LS_WGU)};
                  pg8::MoeGuOrder S; S.init(ntile * 256, 2 * DFF, F.G, F.bid); S.tile_e = TILE_E; S.estride = (size_t)2 * DFF * D;
                  const int nd = ntile * (D / 256), rmax = (nd + F.G - 1) / F.G; int Hh = nd - (rmax - 1) * F.G; if (Hh >= F.G) Hh = 0;
                  S.H = Hh; S.NL = F.G - Hh; S.gH = (S.nwg - 3 * S.NL) / F.G; if (S.gH < 0) S.gH = 0; S.cnt = mcnt; S.pend = -1; S.lead = (F.tid == 0);
                  pg8::EpiSwiGLU<true, true> E{(unsigned char*)(ws + WS_T + T_ACT), DFF, (float)(1 << LS_ACT), nullptr};
                  pg8::gemm_phase<pg8::EpiSwiGLU<true, true>, pg8::MoeGuOrder, true, true, true>(ring, g, S, E, F.wave);
                  S.flush(); }
                { pg8::Gemm g{(const bf16*)(ws + WS_T + T_ACT), (const bf16*)(ws + WS_MD), ntile * 256, D, DFF / 2, SB(LS_ACT), SB(LS_WD)};
                  pg8::MoeDnOrder S; S.init(ntile * 256, D, F.G, F.bid); S.tile_e = TILE_E; S.estride = (size_t)D * DFF;
                  S.cnt = mcnt; S.need = 2 * DFF / 256;
                  pg8::EpiBf16Plain E{(bf16*)(ws + WS_T + T_YPERM), D};
                  pg8::gemm_phase<pg8::EpiBf16Plain, pg8::MoeDnOrder, true, true, true>(ring, g, S, E, F.wave); } }
            PH_END(pb + 9)
        }
        if constexpr (L == 1) { PH_BEGIN(pb + 11, 11) norm_phase<3, true>(P, F, L, H, P.in[I_PLE_NORM] + L * D, true); PH_END(pb + 11) }
        PH_BEGIN(pb + 12, 12) {
            if constexpr (L == 0) rstd_fill(P, F);
            { int kple = PLE; asm volatile("" : "+s"(kple)); pg8::Gemm g{(const bf16*)(ws + WS_T + (L == 0 ? T_PB0 : T_PB)), (const bf16*)(ws + WS_WPP) + (size_t)L * D * PLE, M, D, kple, 0, 0}; pg8::StaticOrder S; S.init(M, D, F.G, F.bid);
              pg8::EpiBf16Plain E{(bf16*)(ws + WS_T + T_PP), D};
              pg8::gemm_phase<pg8::EpiBf16Plain, pg8::StaticOrder, true, true>(ring, g, S, E, F.wave); }
            { pg8::Gemm g{L == 0 ? H : HN, (const bf16*)(ws + WS_WPG) + (size_t)L * D * D, M, D, L == 1 ? D / 2 : D, L == 1 ? SB(LS_HN) : 0, L == 1 ? SB(LS_WGU) : 0}; pg8::StaticOrder S; S.init(M, D, F.G, F.bid);
              pg8::EpiRes<2, false, false, L == 0> E{L == 0 ? Hnext : H, H, (const bf16*)(ws + WS_T + T_PP), D, nullptr, nullptr, (const LAS float*)(F.lds + LDS_RSTD)};
              pg8::gemm_phase<pg8::EpiRes<2, false, false, L == 0>, pg8::StaticOrder, true, true, L == 1>(ring, g, S, E, F.wave); } }
        PH_END(pb + 12)
    }
__global__ void __launch_bounds__(NTHR, 2) fwd(Params P) {
    extern __shared__ __attribute__((aligned(16))) unsigned char lds_raw[];
    Frame F;
    F.lds = (LAS unsigned char*)lds_raw;
    F.MISC = (volatile LAS unsigned*)(F.lds + MISC_OFF);
    F.tid = threadIdx.x; F.lane = F.tid & 63; F.wave = __builtin_amdgcn_readfirstlane(F.tid >> 6);
    F.G = GRID; F.bid = blockIdx.x;
    unsigned char* ws = P.ws;
    for (int u = F.tid; u < (LDS_BYTES - MISC_OFF) / 4; u += NTHR) ((LAS unsigned*)(F.lds + MISC_OFF))[u] = 0u;
    __syncthreads();
    XcdBarrier bar = xcd_barrier_post((unsigned*)(ws + WS_CTL) + CW_BAR, F.MISC + 8);
    const int lo = P.ph_lo, hi = P.ph_hi;
    LAS unsigned char* ring = F.lds;
    bf16* HN = (bf16*)(ws + WS_HN); bf16* H = (bf16*)(ws + WS_H) + (size_t)M * D;

    PH_BEGIN(0, 13) prologue_phase<0>(P, F); PH_END(0)

    layer_phases<0>(P, F, bar, lo, hi);
    layer_phases<1>(P, F, bar, lo, hi);
    PH_BEGIN(27, 14) norm_phase<4, true>(P, F, 0, H, P.in[I_FINAL_NORM], false); PH_END(27)
#undef PH_BEGIN
#undef PH_END
}

extern "C" void kernel_launch(void* const* d_in, const int* in_sizes, int n_in, void* d_out, int out_size, void* d_ws, size_t ws_size, hipStream_t stream) {
    static int grid = 0;
    if (grid == 0) {
        if (n_in != 30 || out_size != M * D || ws_size < WS_END) { fprintf(stderr, "kernel_launch: unexpected shapes (n_in %d out %d ws %zu, need %zu)\n", n_in, out_size, ws_size, (size_t)WS_END); grid = -1; return; }
        int dev = 0, cus = 0, per_cu = 0;
        if (hipGetDevice(&dev) != hipSuccess || hipDeviceGetAttribute(&cus, hipDeviceAttributeMultiprocessorCount, dev) != hipSuccess) { grid = -1; return; }
        if (hipFuncSetAttribute((const void*)fwd, hipFuncAttributeMaxDynamicSharedMemorySize, LDS_BYTES) != hipSuccess) { fprintf(stderr, "kernel_launch: hipFuncSetAttribute failed\n"); grid = -1; return; }
        if (hipOccupancyMaxActiveBlocksPerMultiprocessor(&per_cu, (const void*)fwd, NTHR, LDS_BYTES) != hipSuccess || per_cu < 1) fprintf(stderr, "kernel_launch: occupancy query says %d\n", per_cu);
        (void)hipGetLastError();
        grid = GRID;
    }
    if (grid < 0) return;
    (void)hipMemsetAsync((char*)d_ws + WS_CTL, 0, CTL_ZERO_BYTES, stream);
    Params p{};
    for (int i = 0; i < 30; ++i) p.in[i] = (const float*)d_in[i];
    p.out = (float*)d_out; p.ws = (unsigned char*)d_ws;
#if MK_SPLIT
    for (int k = 0; k < NPH; ++k) { if (k == 1 + 8) continue; p.ph_lo = k; p.ph_hi = k + 1; hipLaunchKernelGGL(fwd, dim3(grid), dim3(NTHR), LDS_BYTES, stream, p); }
#else
    p.ph_lo = 0; p.ph_hi = NPH; hipLaunchKernelGGL(fwd, dim3(grid), dim3(NTHR), LDS_BYTES, stream, p);
#endif
}
```
